# Optimizing an MI355X kernel written in HIP

```python
import jax, jax.numpy as jnp
from jax import lax
import numpy as np

D_MODEL = 4096
BATCH = 1
SEQ = 16384
DEPTH = 2

CHUNK = 64
EPS = 1e-6

CONV_WIDTH = D_MODEL // 2
CONV_K = 3
SGU_WIDTH = D_MODEL // 2
SGU_HEADS = 16
SGU_BLOCK = 128
EV_IN = 3 * CONV_WIDTH + 2 * SGU_WIDTH
EV_MIX = CONV_WIDTH + SGU_WIDTH

SSM_INNER = 2 * D_MODEL
SSM_HEADDIM = 64
SSM_HEADS = SSM_INNER // SSM_HEADDIM
SSM_GROUPS = 8
SSM_STATE = 128
SSM_CONV_K = 4
SSM_CHUNK = CHUNK
SSM_CONV_DIM = SSM_INNER + 2 * SSM_GROUPS * SSM_STATE
OD_IN = SSM_INNER + SSM_CONV_DIM + SSM_HEADS

PEER_HEADS = 8
PEER_NKEYS = 128
PEER_EXPERTS = PEER_NKEYS * PEER_NKEYS
PEER_QDIM = 256
PEER_HALF = PEER_QDIM // 2
PEER_TOPK = 16
PEER_BLOCK = 128

N_EVEN = (DEPTH + 1) // 2
N_ODD = DEPTH // 2

kernel_name = "hybrid_conv_sgu_ssd_peer_trunk"


def rms_norm(x, g):
    xf = x.astype(jnp.float32)
    y = xf * lax.rsqrt(jnp.mean(xf * xf, axis=-1, keepdims=True) + EPS)
    return (y * g.astype(jnp.float32)).astype(x.dtype)


def layer_norm(x, g):
    xf = x.astype(jnp.float32)
    mu = jnp.mean(xf, axis=-1, keepdims=True)
    var = jnp.mean(jnp.square(xf - mu), axis=-1, keepdims=True)
    return ((xf - mu) * lax.rsqrt(var + EPS) * g.astype(jnp.float32)).astype(x.dtype)


def causal_dwconv(x, w):
    K = w.shape[0]
    S = x.shape[1]
    xp = jnp.pad(x, ((0, 0), (K - 1, 0), (0, 0)))
    y = xp[:, 0:S] * w[0]
    for k in range(1, K):
        y = y + xp[:, k:k + S] * w[k]
    return y


def conv_sgu_mixer(h, w_in, conv_w, sgu_norm, sgu_w, sgu_b, w_out):
    Bsz, S, _ = h.shape
    proj = h @ w_in
    gb, gc, xt, zu, zv = jnp.split(
        proj, [CONV_WIDTH, 2 * CONV_WIDTH, 3 * CONV_WIDTH, 3 * CONV_WIDTH + SGU_WIDTH], axis=-1)
    y_conv = gb * causal_dwconv(gc * xt, conv_w)
    u = jax.nn.gelu(zu)
    v = layer_norm(jax.nn.gelu(zv), sgu_norm)
    nb = S // SGU_BLOCK
    vb = v.reshape(Bsz, nb, SGU_BLOCK, SGU_HEADS, SGU_WIDTH // SGU_HEADS)
    tril = jnp.tril(jnp.ones((SGU_BLOCK, SGU_BLOCK), dtype=bool))
    ws = jnp.where(tril[None], sgu_w, jnp.zeros_like(sgu_w))
    sv = jnp.einsum('gqp,bnpgc->bnqgc', ws, vb) + jnp.transpose(sgu_b)[:, :, None]
    y_sgu = u * sv.reshape(Bsz, S, SGU_WIDTH)
    return jnp.concatenate([y_conv, y_sgu], axis=-1) @ w_out


def ssd_scan(x, dt, A, Bm, Cm):
    Bsz, S, H, P = x.shape
    G, N = SSM_GROUPS, SSM_STATE
    R = H // G
    L = SSM_CHUNK
    nc = S // L
    xdt = x.astype(jnp.float32) * dt[..., None]
    dA = dt * A

    def to_chunks(t):
        return jnp.moveaxis(t.reshape(Bsz, nc, L, *t.shape[2:]), 1, 0)

    xs = to_chunks(xdt.reshape(Bsz, S, G, R, P))
    As = to_chunks(dA.reshape(Bsz, S, G, R))
    Bs = to_chunks(Bm.astype(jnp.float32))
    Cs = to_chunks(Cm.astype(jnp.float32))
    causal = jnp.tril(jnp.ones((L, L), dtype=bool))[None, :, :, None, None]

    def step(state, inp):
        xc, ac, bc, cc = inp
        acs = jnp.cumsum(ac, axis=1)
        seg = acs[:, :, None] - acs[:, None, :]
        decay = jnp.exp(jnp.where(causal, seg, -jnp.inf))
        cb = jnp.einsum('blgn,bsgn->blsg', cc, bc)
        y_diag = jnp.einsum('blsg,blsgr,bsgrp->blgrp', cb, decay, xc)
        y_off = jnp.einsum('blgn,bgrpn,blgr->blgrp', cc, state, jnp.exp(acs))
        to_end = jnp.exp(acs[:, -1:] - acs)
        new_state = state * jnp.exp(acs[:, -1])[..., None, None] + jnp.einsum(
            'blgn,blgr,blgrp->bgrpn', bc, to_end, xc)
        return new_state, y_diag + y_off

    init = jnp.zeros((Bsz, G, R, P, N), jnp.float32)
    _, ys = lax.scan(step, init, (xs, As, Bs, Cs))
    return jnp.moveaxis(ys, 0, 1).reshape(Bsz, S, H, P)


def gated_group_rms(y, z, g):
    yz = (y * jax.nn.silu(z)).astype(jnp.float32)
    shp = yz.shape
    yg = yz.reshape(*shp[:-1], SSM_GROUPS, shp[-1] // SSM_GROUPS)
    yg = yg * lax.rsqrt(jnp.mean(yg * yg, axis=-1, keepdims=True) + EPS)
    return (yg.reshape(shp) * g.astype(jnp.float32)).astype(y.dtype)


def mamba2_mixer(h, w_in, conv_w, conv_b, dt_bias, a_log, d_skip, norm_g, w_out):
    Bsz, S, _ = h.shape
    proj = h @ w_in
    z, xbc, dt = jnp.split(proj, [SSM_INNER, SSM_INNER + SSM_CONV_DIM], axis=-1)
    xbc = jax.nn.silu(causal_dwconv(xbc, conv_w) + conv_b)
    xs, Bm, Cm = jnp.split(xbc, [SSM_INNER, SSM_INNER + SSM_GROUPS * SSM_STATE], axis=-1)
    dt = jax.nn.softplus(dt.astype(jnp.float32) + dt_bias.astype(jnp.float32))
    A = -jnp.exp(a_log.astype(jnp.float32))
    xh = xs.reshape(Bsz, S, SSM_HEADS, SSM_HEADDIM)
    y = ssd_scan(xh, dt, A,
                 Bm.reshape(Bsz, S, SSM_GROUPS, SSM_STATE),
                 Cm.reshape(Bsz, S, SSM_GROUPS, SSM_STATE))
    y = y + d_skip.astype(jnp.float32)[:, None] * xh.astype(jnp.float32)
    y = y.reshape(Bsz, S, SSM_INNER).astype(h.dtype)
    return gated_group_rms(y, z, norm_g) @ w_out


def peer_ffn(h, wq, keys, u_tab, v_tab):
    Bsz, S, D = h.shape
    T = Bsz * S
    H, K = PEER_HEADS, PEER_TOPK
    xt = h.reshape(T, D)
    q = (xt @ wq).reshape(T, H, 2, PEER_HALF)
    s = jnp.einsum('thic,hikc->thik', q, keys).astype(jnp.float32)
    s_top, i_top = lax.top_k(s, K)
    cand = s_top[:, :, 0, :, None] + s_top[:, :, 1, None, :]
    cand_idx = i_top[:, :, 0, :, None] * PEER_NKEYS + i_top[:, :, 1, None, :]
    best, pos = lax.top_k(cand.reshape(T, H, K * K), K)
    expert = jnp.take_along_axis(cand_idx.reshape(T, H, K * K), pos, axis=-1)
    gate = jax.nn.softmax(best, axis=-1).astype(h.dtype)
    nb = T // PEER_BLOCK

    def block(args):
        xb, eb, gb = args
        act = jax.nn.gelu(jnp.einsum('td,thkd->thk', xb, u_tab[eb]))
        return jnp.einsum('thk,thkd->td', gb * act, v_tab[eb])

    out = lax.map(block, (xt.reshape(nb, PEER_BLOCK, D),
                          expert.reshape(nb, PEER_BLOCK, H, K),
                          gate.reshape(nb, PEER_BLOCK, H, K)))
    return out.reshape(Bsz, S, D)


def setup_inputs(seed: int = 0) -> dict:
    key = jax.random.key(seed)
    ks = jax.random.split(key, 24)
    f32 = jnp.float32

    def nrm(k, shape, scale):
        return jax.random.normal(k, shape, f32) * scale

    dt0 = jnp.exp(jax.random.uniform(ks[11], (N_ODD, SSM_HEADS), f32,
                                     np.log(1e-3).astype(np.float32), np.log(1e-1).astype(np.float32)))
    return {
        'x': nrm(ks[0], (BATCH, SEQ, D_MODEL), 1.0),
        'mix_norm': 1.0 + nrm(ks[1], (DEPTH, D_MODEL), 0.02),
        'ffn_norm': 1.0 + nrm(ks[2], (DEPTH, D_MODEL), 0.02),
        'final_norm': 1.0 + nrm(ks[3], (D_MODEL,), 0.02),
        'ev_w_in': nrm(ks[4], (N_EVEN, D_MODEL, EV_IN), D_MODEL ** -0.5),
        'ev_conv_w': nrm(ks[5], (N_EVEN, CONV_K, CONV_WIDTH), CONV_K ** -0.5),
        'ev_sgu_norm': 1.0 + nrm(ks[6], (N_EVEN, SGU_WIDTH), 0.02),
        'ev_sgu_w': nrm(ks[7], (N_EVEN, SGU_HEADS, SGU_BLOCK, SGU_BLOCK), SGU_BLOCK ** -0.5),
        'ev_sgu_b': 1.0 + nrm(ks[8], (N_EVEN, SGU_HEADS, SGU_BLOCK), 0.1),
        'ev_w_out': nrm(ks[9], (N_EVEN, EV_MIX, D_MODEL), EV_MIX ** -0.5),
        'od_w_in': nrm(ks[10], (N_ODD, D_MODEL, OD_IN), D_MODEL ** -0.5),
        'od_conv_w': nrm(ks[12], (N_ODD, SSM_CONV_K, SSM_CONV_DIM), SSM_CONV_K ** -0.5),
        'od_conv_b': nrm(ks[13], (N_ODD, SSM_CONV_DIM), 0.02),
        'od_dt_bias': dt0 + jnp.log(-jnp.expm1(-dt0)),
        'od_a_log': jnp.log(jax.random.uniform(ks[14], (N_ODD, SSM_HEADS), f32, 1.0, 16.0)),
        'od_d': 1.0 + nrm(ks[15], (N_ODD, SSM_HEADS), 0.1),
        'od_norm': 1.0 + nrm(ks[16], (N_ODD, SSM_INNER), 0.02),
        'od_w_out': nrm(ks[17], (N_ODD, SSM_INNER, D_MODEL), SSM_INNER ** -0.5),
        'peer_wq': nrm(ks[18], (DEPTH, D_MODEL, PEER_HEADS * PEER_QDIM), D_MODEL ** -0.5),
        'peer_keys': nrm(ks[19], (DEPTH, PEER_HEADS, 2, PEER_NKEYS, PEER_HALF), PEER_HALF ** -0.5),
        'peer_u': nrm(ks[20], (DEPTH, PEER_EXPERTS, D_MODEL), D_MODEL ** -0.5),
        'peer_v': nrm(ks[21], (DEPTH, PEER_EXPERTS, D_MODEL), PEER_HEADS ** -0.5),
    }


def reference(x, mix_norm, ffn_norm, final_norm,
              ev_w_in, ev_conv_w, ev_sgu_norm, ev_sgu_w, ev_sgu_b, ev_w_out,
              od_w_in, od_conv_w, od_conv_b, od_dt_bias, od_a_log, od_d, od_norm, od_w_out,
              peer_wq, peer_keys, peer_u, peer_v):
    h = x
    for i in range(DEPTH):
        hn = rms_norm(h, mix_norm[i])
        j = i // 2
        if i % 2 == 0:
            mix = conv_sgu_mixer(hn, ev_w_in[j], ev_conv_w[j], ev_sgu_norm[j],
                                 ev_sgu_w[j], ev_sgu_b[j], ev_w_out[j])
        else:
            mix = mamba2_mixer(hn, od_w_in[j], od_conv_w[j], od_conv_b[j], od_dt_bias[j],
                               od_a_log[j], od_d[j], od_norm[j], od_w_out[j])
        h = h + mix
        h = h + peer_ffn(rms_norm(h, ffn_norm[i]), peer_wq[i], peer_keys[i], peer_u[i], peer_v[i])
    return rms_norm(h, final_norm)
```

```cpp
#include <hip/hip_runtime.h>
#include <cstdio>
#include <cstdint>
#define MK_ONE_LAUNCH 1
namespace pg8 {
#define PG8_LAS __attribute__((address_space(3)))
typedef unsigned short bf16_t;
typedef short bf16x8 __attribute__((ext_vector_type(8)));
typedef float f32x4 __attribute__((ext_vector_type(4)));
typedef unsigned u32x4 __attribute__((ext_vector_type(4)));
constexpr int BM = 256, BK = 64, HALF = 128, HTB = HALF * BK * 2  , STAGE_BYTES = 8 * HTB, NXCD = 8, WGM = 8;

__host__ __device__ __forceinline__ int lds_byte(int r, int c) { const int st = (r >> 4) * 2 + (c >> 5), rr = r & 15, cc = c & 31, ob = rr * 64 + cc * 2; return st * 1024 + (ob ^ (((ob >> 9) & 1) << 5)); }
__host__ __device__ __forceinline__ void stage_rc(int b, int& R, int& C) { const int st = b / 1024, sb = b % 1024, swz = sb ^ (((sb >> 9) & 1) << 5); R = (st >> 1) * 16 + swz / 64; C = (st & 1) * 32 + (swz % 64) / 2; }
__host__ __device__ __forceinline__ int perm32(int rho) { const int n = rho >> 4, i = rho & 15; return 8 * (i >> 2) + 4 * n + (i & 3); }

struct Unit { int pm, pn; };
struct Gemm { const bf16_t* A; const bf16_t* Bt; int M, N, K; };

struct StaticOrder {
    int nM, nN, nwg, G, c;
    __host__ __device__ void init(int M, int N, int G_, int c_) { nM = M / BM; nN = N / BM; nwg = nM * nN; G = G_; c = c_; }
    __host__ __device__ bool next(int i, Unit& u) const {
        const long L = (long)i * G + c; if (L >= nwg) return false;
        int wgid = (int)L; { const int q = nwg / NXCD, r = nwg % NXCD, xcd = wgid % NXCD, off = wgid / NXCD; wgid = (xcd < r ? xcd * (q + 1) : r * (q + 1) + (xcd - r) * q) + off; }
        const int nig = WGM * nN, gid = wgid / nig, fm = gid * WGM, gsz = (nM - fm) < WGM ? (nM - fm) : WGM;
        u.pm = fm + ((wgid % nig) % gsz); u.pn = (wgid % nig) / gsz; return true;
    }
    __device__ __forceinline__ void a_ready(const Unit&) const {}
    __device__ __forceinline__ void done(const Unit&) const {}
};

typedef float f32x2c __attribute__((ext_vector_type(2))); typedef __bf16 bf16x2c __attribute__((ext_vector_type(2)));
__device__ __forceinline__ unsigned cvt_pk_bf16(float lo, float hi) { const f32x2c v = {lo, hi}; return __builtin_bit_cast(unsigned, __builtin_convertvector(v, bf16x2c)); }
typedef unsigned u32x2 __attribute__((ext_vector_type(2)));
typedef int i32x4 __attribute__((ext_vector_type(4)));
typedef int i32x8 __attribute__((ext_vector_type(8)));
typedef int i32x16 __attribute__((ext_vector_type(16)));
typedef int i32x32 __attribute__((ext_vector_type(32)));
__device__ __forceinline__ float gelu_tanh(float x) {
    const float u = x * (1.0f + 0.044715f * x * x);
    const float e = __builtin_amdgcn_exp2f(-2.302208198f * u);
    return x * __builtin_amdgcn_rcpf(1.0f + e);
}
struct EpiBf16G {
    static constexpr bool PERM = true, AFTER_DRAIN = false;
    bf16_t* O; int ldc; int gelu_from; float scale; const float* rs = nullptr;
    __device__ __forceinline__ void operator()(const f32x4 (&acc)[2][2][4][2], const Unit& u, int wr, int wc, int fr, int fq) const {
        const int row0 = u.pm * BM + wr * 64 + fr, col0 = u.pn * BM + wc * 32 + 8 * fq;
        const bool act = u.pn >= gelu_from;
#pragma unroll
        for (int ai = 0; ai < 2; ++ai)
#pragma unroll
            for (int m = 0; m < 4; ++m) { bf16_t* rowp = O + (size_t)(row0 + ai * HALF + m * 16) * ldc + col0; const float sc_ = rs ? scale * rs[row0 + ai * HALF + m * 16] : scale;
#pragma unroll
                for (int bj = 0; bj < 2; ++bj) { f32x4 v0 = acc[ai][bj][m][0] * sc_, v1 = acc[ai][bj][m][1] * sc_;
                    if (act) {
#pragma unroll
                        for (int j = 0; j < 4; ++j) { v0[j] = gelu_tanh(v0[j]); v1[j] = gelu_tanh(v1[j]); } }
                    u32x4 w; w.x = cvt_pk_bf16(v0[0], v0[1]); w.y = cvt_pk_bf16(v0[2], v0[3]); w.z = cvt_pk_bf16(v1[0], v1[1]); w.w = cvt_pk_bf16(v1[2], v1[3]);
                    *(u32x4*)(rowp + bj * HALF) = w; } }
    }
};
struct EpiResF32 {
    static constexpr bool PERM = false, AFTER_DRAIN = false;
    const float* base; float* out; int ldc; float scale;
    __device__ __forceinline__ void operator()(const f32x4 (&acc)[2][2][4][2], const Unit& u, int wr, int wc, int fr, int fq) const {
        const int row0 = u.pm * BM + wr * 64 + fr, col0 = u.pn * BM + wc * 32 + 4 * fq;
#pragma unroll
        for (int ai = 0; ai < 2; ++ai)
#pragma unroll
            for (int m = 0; m < 4; ++m) { const size_t off = (size_t)(row0 + ai * HALF + m * 16) * ldc + col0;
                f32x4 bs[2][2];
#pragma unroll
                for (int bj = 0; bj < 2; ++bj)
#pragma unroll
                    for (int n = 0; n < 2; ++n) bs[bj][n] = *(const f32x4*)(base + off + bj * HALF + n * 16);
#pragma unroll
                for (int bj = 0; bj < 2; ++bj)
#pragma unroll
                    for (int n = 0; n < 2; ++n) *(f32x4*)(out + off + bj * HALF + n * 16) = bs[bj][n] + acc[ai][bj][m][n] * scale;
                asm volatile("" ::: "memory"); }
    }
};
template <bool BB, bool OB> struct EpiRes {
    static constexpr bool PERM = false, AFTER_DRAIN = false;
    const void* base; void* out; int ldc; float scale;
    __device__ __forceinline__ void operator()(const f32x4 (&acc)[2][2][4][2], const Unit& u, int wr, int wc, int fr, int fq) const {
        const int row0 = u.pm * BM + wr * 64 + fr, col0 = u.pn * BM + wc * 32 + 4 * fq;
#pragma unroll
        for (int ai = 0; ai < 2; ++ai)
#pragma unroll
            for (int m = 0; m < 4; ++m) { const size_t off = (size_t)(row0 + ai * HALF + m * 16) * ldc + col0;
                f32x4 bs[2][2];
#pragma unroll
                for (int bj = 0; bj < 2; ++bj)
#pragma unroll
                    for (int n = 0; n < 2; ++n) {
                        if constexpr (BB) { const u32x2 t = *(const u32x2*)((const bf16_t*)base + off + bj * HALF + n * 16);
                            bs[bj][n] = (f32x4){__uint_as_float(t.x << 16), __uint_as_float(t.x & 0xffff0000u), __uint_as_float(t.y << 16), __uint_as_float(t.y & 0xffff0000u)}; }
                        else bs[bj][n] = *(const f32x4*)((const float*)base + off + bj * HALF + n * 16); }
#pragma unroll
                for (int bj = 0; bj < 2; ++bj)
#pragma unroll
                    for (int n = 0; n < 2; ++n) { const f32x4 r = bs[bj][n] + acc[ai][bj][m][n] * scale;
                        if constexpr (OB) { u32x2 w; w.x = cvt_pk_bf16(r[0], r[1]); w.y = cvt_pk_bf16(r[2], r[3]); *(u32x2*)((bf16_t*)out + off + bj * HALF + n * 16) = w; }
                        else *(f32x4*)((float*)out + off + bj * HALF + n * 16) = r; }
                asm volatile("" ::: "memory"); }
    }
};
struct EpiPeerU {
    static constexpr bool PERM = true, AFTER_DRAIN = false;
    bf16_t* Gm; int ldc;
    __device__ __forceinline__ void operator()(const f32x4 (&acc)[2][2][4][2], const Unit& u, int wr, int wc, int fr, int fq) const {
        const int row0 = u.pm * BM + wr * 64 + fr, col0 = u.pn * BM + wc * 32 + 8 * fq;
#pragma unroll
        for (int ai = 0; ai < 2; ++ai) {
            u32x4 gv[4][2];
#pragma unroll
            for (int m = 0; m < 4; ++m)
#pragma unroll
                for (int bj = 0; bj < 2; ++bj) gv[m][bj] = *(const u32x4*)(Gm + (size_t)(row0 + ai * HALF + m * 16) * ldc + col0 + bj * HALF);
#pragma unroll
            for (int m = 0; m < 4; ++m)
#pragma unroll
                for (int bj = 0; bj < 2; ++bj) { const u32x4 g = gv[m][bj];
                    if ((g.x | g.y | g.z | g.w) != 0u) { const f32x4 v0 = acc[ai][bj][m][0], v1 = acc[ai][bj][m][1]; u32x4 w;
                        w.x = cvt_pk_bf16(__uint_as_float(g.x << 16) * gelu_tanh(v0[0]), __uint_as_float(g.x & 0xffff0000u) * gelu_tanh(v0[1]));
                        w.y = cvt_pk_bf16(__uint_as_float(g.y << 16) * gelu_tanh(v0[2]), __uint_as_float(g.y & 0xffff0000u) * gelu_tanh(v0[3]));
                        w.z = cvt_pk_bf16(__uint_as_float(g.z << 16) * gelu_tanh(v1[0]), __uint_as_float(g.z & 0xffff0000u) * gelu_tanh(v1[1]));
                        w.w = cvt_pk_bf16(__uint_as_float(g.w << 16) * gelu_tanh(v1[2]), __uint_as_float(g.w & 0xffff0000u) * gelu_tanh(v1[3]));
                        *(u32x4*)(Gm + (size_t)(row0 + ai * HALF + m * 16) * ldc + col0 + bj * HALF) = w; } }
        }
    }
};

struct EpiPeerU8 {
    static constexpr bool PERM = true, AFTER_DRAIN = false;
    unsigned char* Gm; int ldc; float sc;
    __device__ __forceinline__ void operator()(const f32x4 (&acc)[2][2][4][2], const Unit& u, int wr, int wc, int fr, int fq) const {
        const int row0 = u.pm * BM + wr * 64 + fr, col0 = u.pn * BM + wc * 32 + 8 * fq;
#pragma unroll
        for (int ai = 0; ai < 2; ++ai)
#pragma unroll
            for (int m = 0; m < 4; ++m) { u32x2 gv[2];
#pragma unroll
                for (int bj = 0; bj < 2; ++bj) gv[bj] = *(const u32x2*)(Gm + (size_t)(row0 + ai * HALF + m * 16) * ldc + col0 + bj * HALF);
#pragma unroll
                for (int bj = 0; bj < 2; ++bj) { const u32x2 g = gv[bj];
                    if (__builtin_amdgcn_ballot_w64((g.x | g.y) != 0u) != 0ull) { unsigned w0 = 0u, w1 = 0u;
#define PEER_POS(GW, AV, K, WOUT) if (__builtin_amdgcn_ballot_w64((((GW) >> (8 * (K))) & 0xffu) != 0u) != 0ull) { const float p_ = __builtin_amdgcn_cvt_f32_fp8((int)(GW), K) * gelu_tanh((AV)[K] * sc); \
                            WOUT |= ((unsigned)__builtin_amdgcn_cvt_pk_fp8_f32(p_, 0.f, 0, false) & 0xffu) << (8 * (K)); }
                        PEER_POS(g.x, acc[ai][bj][m][0], 0, w0) PEER_POS(g.x, acc[ai][bj][m][0], 1, w0) PEER_POS(g.x, acc[ai][bj][m][0], 2, w0) PEER_POS(g.x, acc[ai][bj][m][0], 3, w0)
                        PEER_POS(g.y, acc[ai][bj][m][1], 0, w1) PEER_POS(g.y, acc[ai][bj][m][1], 1, w1) PEER_POS(g.y, acc[ai][bj][m][1], 2, w1) PEER_POS(g.y, acc[ai][bj][m][1], 3, w1)
#undef PEER_POS
                        if ((g.x | g.y) != 0u) { u32x2 w; w.x = w0; w.y = w1; *(u32x2*)(Gm + (size_t)(row0 + ai * HALF + m * 16) * ldc + col0 + bj * HALF) = w; } } }
                asm volatile("" ::: "memory"); }
    }
};
#define PG8_GAS __attribute__((address_space(1)))
__device__ __forceinline__ bf16x8 frag_lo8(const PG8_LAS unsigned char* p) { const u32x2 t = *(const volatile PG8_LAS u32x2*)p; const u32x4 r = __builtin_shufflevector(t, t, 0, 1, -1, -1); return __builtin_bit_cast(bf16x8, r); }
template <class Epi, class Sched, bool ALIGN_EPI = false, bool SP2 = false, bool FP8 = false, int FMT = 0, bool TLA = false, bool TLB = false>
__device__ __forceinline__ void gemm_phase(PG8_LAS unsigned char* lds, const Gemm g, const Sched& S, const Epi& E, const int tid) {
    const int wid = __builtin_amdgcn_readfirstlane(tid >> 6), lane = tid & 63, wr = wid >> 2, wc = wid & 3, fr = lane & 15, fq = lane >> 4;
    constexpr bool F6D = FP8 && FMT == 2;
    constexpr bool F6A = F6D, F6B = FP8 && (FMT == 2 || FMT == 3);
    const int K = g.K, nt = K / BK, PITCH = K * 2;
    unsigned voffA[2], voffB[2];
#pragma unroll
    for (int i = 0; i < 2; ++i) {
        const unsigned v6 = (unsigned)(i == 0 ? wid * 1024 + 16 * lane : 8192 + wid * 512 + 16 * (lane & 31));
        int R, C; stage_rc(tid * 16 + i * 8192, R, C); const int Rb = Epi::PERM ? ((R & ~31) + perm32(R & 31)) : R;
        voffA[i] = F6A ? v6 : TLA ? (unsigned)(tid * 16 + i * 8192) : (unsigned)(R * K + C) * 2u; voffB[i] = F6B ? v6 : TLB ? (unsigned)(tid * 16 + i * 8192) : (unsigned)(Rb * K + C) * 2u; }
    const size_t kstepA = F6A ? (size_t)12288 : TLA ? (size_t)16384 : (size_t)(BK * 2), kstepB = F6B ? (size_t)12288 : TLB ? (size_t)16384 : (size_t)(BK * 2);
    const size_t hstepA = F6A ? (size_t)nt * 12288 : TLA ? (size_t)nt * 16384 : (size_t)HALF * PITCH, hstepB = F6B ? (size_t)nt * 12288 : TLB ? (size_t)nt * 16384 : (size_t)HALF * PITCH;
    const size_t tstepA = 2 * hstepA, tstepB = 2 * hstepB;
    const unsigned ldsw = (unsigned)wid * 1024u;
    const int aoff = F6A ? (wr * 64 + fr) * 96 + 16 * fq : lds_byte(wr * 64 + fr, fq * 8), boff = F6B ? (wc * 32 + fr) * 96 + 16 * fq : lds_byte(wc * 32 + fr, fq * 8);
    const int s2off = 64 + 8 * (fq ^ ((fr >> 3) << 1)) - 16 * fq;
    constexpr int FSTRA = F6A ? 1536 : 2048, FSTRB = F6B ? 1536 : 2048;
#define PG8_SA(b, h) (((b) * 2 + (h)) * HTB)
#define PG8_SB(b, h) ((4 + (b) * 2 + (h)) * HTB)
#define PG8_STAGE(bufoff, gbase, voff) PG8_STAGE_((bufoff), (gbase), voff, (PG8_IS6(voff)))
#define PG8_IS6(voff) ((const void*)(voff) == (const void*)voffA ? F6A : F6B)
#define PG8_STAGE_(bufoff, gbase, voff, f6_) do { _Pragma("unroll") for (int _i = 0; _i < 2; ++_i) { unsigned vo_ = (voff)[_i]; asm volatile("" : "+v"(vo_));     \
        if (f6_) { if (_i == 0) __builtin_amdgcn_global_load_lds((const PG8_GAS unsigned*)((const PG8_GAS char*)(gbase) + vo_), (PG8_LAS unsigned*)(lds + (bufoff) + ldsw), 16, 0, 0); \
            else if (lane < 32) __builtin_amdgcn_global_load_lds((const PG8_GAS unsigned*)((const PG8_GAS char*)(gbase) + vo_), (PG8_LAS unsigned*)(lds + (bufoff) + 8192 + (ldsw >> 1)), 16, 0, 0); } \
        else __builtin_amdgcn_global_load_lds((const PG8_GAS unsigned*)((const PG8_GAS char*)(gbase) + vo_), (PG8_LAS unsigned*)(lds + (bufoff) + ldsw + _i * 8192), 16, 0, 0); } } while (0)
#define PG8_FRAG(ptr, k, f6_) (((f6_) && (k) == 1) ? frag_lo8(ptr) : *(const PG8_LAS bf16x8*)(ptr))
#define PG8_LDA(dst, b, h) do { _Pragma("unroll") for (int m = 0; m < 4; ++m) _Pragma("unroll") for (int k = 0; k < 2; ++k) dst[m][k] = PG8_FRAG(lds + PG8_SA(b, h) + aoff + m * FSTRA + k * (F6A ? s2off : 1024), k, F6A); } while (0)
#define PG8_LDB(dst, b, h) do { _Pragma("unroll") for (int n = 0; n < 2; ++n) _Pragma("unroll") for (int k = 0; k < 2; ++k) dst[n][k] = PG8_FRAG(lds + PG8_SB(b, h) + boff + n * FSTRB + k * (F6B ? s2off : 1024), k, F6B); } while (0)
#define PG8_MMA(ai, bj, At, Bt) do { __builtin_amdgcn_s_setprio(1); _Pragma("unroll") for (int m = 0; m < 4; ++m) _Pragma("unroll") for (int n = 0; n < 2; ++n) { \
        if constexpr (FP8) { const i32x8 a8_ = __builtin_shufflevector(__builtin_bit_cast(i32x4, At[m][0]), __builtin_bit_cast(i32x4, At[m][1]), 0, 1, 2, 3, 4, 5, 6, 7), b8_ = __builtin_shufflevector(__builtin_bit_cast(i32x4, Bt[n][0]), __builtin_bit_cast(i32x4, Bt[n][1]), 0, 1, 2, 3, 4, 5, 6, 7); \
              \
            acc[ai][bj][m][n] = __builtin_amdgcn_mfma_scale_f32_16x16x128_f8f6f4(b8_, a8_, acc[ai][bj][m][n], F6B ? 2 : 0, F6A ? 2 : 0, 0, 0, 0, 0); } \
        else { _Pragma("unroll") for (int k = 0; k < 2; ++k) acc[ai][bj][m][n] = __builtin_amdgcn_mfma_f32_16x16x32_bf16(Bt[n][k], At[m][k], acc[ai][bj][m][n], 0, 0, 0); } } \
        __builtin_amdgcn_s_setprio(0); } while (0)
#define PG8_WAIT_V(n) asm volatile("s_waitcnt vmcnt(" #n ")" ::: "memory")
#define PG8_WAIT_L(n) asm volatile("s_waitcnt lgkmcnt(" #n ")" ::: "memory")
#define PG8_BAR __builtin_amdgcn_s_barrier()
#define PG8_SCHED __builtin_amdgcn_sched_barrier(0)
    Unit cur, nxt; int ui = 0;
    if (!S.next(0, cur)) return;
    f32x4 acc[2][2][4][2];
#pragma unroll
    for (int a = 0; a < 2; ++a)
#pragma unroll
        for (int b = 0; b < 2; ++b)
#pragma unroll
            for (int m = 0; m < 4; ++m)
#pragma unroll
                for (int n = 0; n < 2; ++n) acc[a][b][m][n] = (f32x4){0.f, 0.f, 0.f, 0.f};
    bf16x8 At[4][2], B0[2][2], B1[2][2];
    bf16x8 At1[4][2];
    constexpr bool EARLY_A1 = F6D;
    const PG8_GAS char* cA = (const PG8_GAS char*)g.A + (size_t)cur.pm * tstepA; const PG8_GAS char* cB = (const PG8_GAS char*)g.Bt + (size_t)cur.pn * tstepB;
    S.a_ready(cur);
    if constexpr (SP2) {
        PG8_STAGE(PG8_SB(0, 0), cB, voffB); PG8_STAGE(PG8_SB(0, 1), cB + hstepB, voffB); PG8_STAGE(PG8_SA(0, 0), cA, voffA); PG8_STAGE(PG8_SA(0, 1), cA + hstepA, voffA);
        if (wr == 1) PG8_BAR;
        PG8_WAIT_V(2); PG8_BAR;
        PG8_STAGE(PG8_SB(1, 0), cB + kstepB, voffB); PG8_STAGE(PG8_SA(1, 0), cA + kstepA, voffA); PG8_STAGE(PG8_SB(1, 1), cB + hstepB + kstepB, voffB);
        PG8_WAIT_V(6); PG8_BAR;
    } else {
        PG8_STAGE(PG8_SB(0, 0), cB, voffB); PG8_STAGE(PG8_SA(0, 0), cA, voffA); PG8_STAGE(PG8_SB(0, 1), cB + hstepB, voffB); PG8_STAGE(PG8_SA(0, 1), cA + hstepA, voffA);
        if (wr == 1) PG8_BAR;
        PG8_WAIT_V(4); PG8_BAR;
        PG8_STAGE(PG8_SB(1, 0), cB + kstepB, voffB); PG8_STAGE(PG8_SA(1, 0), cA + kstepA, voffA); PG8_STAGE(PG8_SB(1, 1), cB + hstepB + kstepB, voffB);
        PG8_WAIT_V(6); PG8_BAR;
    }
    for (;;) {
        const bool has_next = S.next(ui + 1, nxt);
        const PG8_GAS char* nA = has_next ? (const PG8_GAS char*)g.A + (size_t)nxt.pm * tstepA : cA; const PG8_GAS char* nB = has_next ? (const PG8_GAS char*)g.Bt + (size_t)nxt.pn * tstepB : cB;
        for (int t = 0; t < nt; t += 2) {
            const bool last = (t == nt - 2);
            const PG8_GAS char* a1 = cA + (size_t)(t + 1) * kstepA;
            const PG8_GAS char* a2 = last ? nA : cA + (size_t)(t + 2) * kstepA; const PG8_GAS char* b2 = last ? nB : cB + (size_t)(t + 2) * kstepB;
            const PG8_GAS char* a3 = a2 + kstepA; const PG8_GAS char* b3 = b2 + kstepB;
            if (last && has_next) S.a_ready(nxt);
            if constexpr (SP2) {
            PG8_LDB(B0, 0, 0); PG8_LDB(B1, 0, 1); PG8_SCHED; PG8_LDA(At, 0, 0); PG8_STAGE(PG8_SA(1, 1), a1 + hstepA, voffA);
            PG8_WAIT_V(8); PG8_WAIT_L(0); PG8_BAR; if constexpr (EARLY_A1) PG8_LDA(At1, 0, 1); PG8_MMA(0, 0, At, B0); PG8_MMA(0, 1, At, B1); PG8_BAR; PG8_SCHED;
            if constexpr (!EARLY_A1) PG8_LDA(At, 0, 1); PG8_STAGE(PG8_SB(0, 0), b2, voffB); PG8_STAGE(PG8_SB(0, 1), b2 + hstepB, voffB); PG8_STAGE(PG8_SA(0, 0), a2, voffA);
            if constexpr (EARLY_A1) PG8_WAIT_V(6); else PG8_WAIT_V(8);
            PG8_WAIT_L(0); PG8_BAR; if constexpr (EARLY_A1) { PG8_MMA(1, 0, At1, B0); PG8_MMA(1, 1, At1, B1); } else { PG8_MMA(1, 0, At, B0); PG8_MMA(1, 1, At, B1); } PG8_BAR; PG8_SCHED;
            PG8_LDB(B0, 1, 0); PG8_LDB(B1, 1, 1); PG8_SCHED; PG8_LDA(At, 1, 0); PG8_STAGE(PG8_SA(0, 1), a2 + hstepA, voffA);
            PG8_WAIT_V(8); PG8_WAIT_L(0); PG8_BAR; if constexpr (EARLY_A1) PG8_LDA(At1, 1, 1); PG8_MMA(0, 0, At, B0); PG8_MMA(0, 1, At, B1); PG8_BAR; PG8_SCHED;
            if constexpr (!EARLY_A1) PG8_LDA(At, 1, 1); PG8_STAGE(PG8_SB(1, 0), b3, voffB); PG8_STAGE(PG8_SB(1, 1), b3 + hstepB, voffB); PG8_STAGE(PG8_SA(1, 0), a3, voffA);
            if constexpr (EARLY_A1) PG8_WAIT_V(6); else PG8_WAIT_V(8);
            PG8_WAIT_L(0); PG8_BAR; if constexpr (EARLY_A1) { PG8_MMA(1, 0, At1, B0); PG8_MMA(1, 1, At1, B1); } else { PG8_MMA(1, 0, At, B0); PG8_MMA(1, 1, At, B1); } PG8_BAR; PG8_SCHED;
            } else {
            PG8_LDB(B0, 0, 0); PG8_SCHED; PG8_LDA(At, 0, 0); PG8_STAGE(PG8_SA(1, 1), a1 + hstepA, voffA);
            PG8_WAIT_L(8); PG8_BAR; PG8_WAIT_L(0); PG8_MMA(0, 0, At, B0); PG8_BAR; PG8_SCHED;
            PG8_LDB(B1, 0, 1); PG8_STAGE(PG8_SB(0, 0), b2, voffB);
            PG8_BAR; PG8_WAIT_L(0); PG8_MMA(0, 1, At, B1); PG8_BAR;
            PG8_LDA(At, 0, 1); PG8_STAGE(PG8_SA(0, 0), a2, voffA);
            PG8_BAR; PG8_WAIT_L(0); PG8_MMA(1, 0, At, B0); PG8_BAR; PG8_SCHED;
            PG8_STAGE(PG8_SB(0, 1), b2 + hstepB, voffB);
            PG8_WAIT_V(6); PG8_BAR; PG8_MMA(1, 1, At, B1); PG8_BAR;
            PG8_LDB(B0, 1, 0); PG8_SCHED; PG8_LDA(At, 1, 0); PG8_STAGE(PG8_SA(0, 1), a2 + hstepA, voffA);
            PG8_WAIT_L(8); PG8_BAR; PG8_WAIT_L(0); PG8_MMA(0, 0, At, B0); PG8_BAR; PG8_SCHED;
            PG8_LDB(B1, 1, 1); PG8_STAGE(PG8_SB(1, 0), b3, voffB);
            PG8_BAR; PG8_WAIT_L(0); PG8_MMA(0, 1, At, B1); PG8_BAR;
            PG8_LDA(At, 1, 1); PG8_STAGE(PG8_SA(1, 0), a3, voffA);
            PG8_BAR; PG8_WAIT_L(0); PG8_MMA(1, 0, At, B0); PG8_BAR; PG8_SCHED;
            PG8_STAGE(PG8_SB(1, 1), b3 + hstepB, voffB);
            PG8_WAIT_V(6); PG8_BAR; PG8_MMA(1, 1, At, B1); PG8_BAR;
            }
        }
        if constexpr (ALIGN_EPI) { if (wr == 0) PG8_BAR; }
        if constexpr (!Epi::AFTER_DRAIN) { E(acc, cur, wr, wc, fr, fq); S.done(cur); }
        if (!has_next) break;
#pragma unroll
        for (int a = 0; a < 2; ++a)
#pragma unroll
            for (int b = 0; b < 2; ++b)
#pragma unroll
                for (int m = 0; m < 4; ++m)
#pragma unroll
                    for (int n = 0; n < 2; ++n) acc[a][b][m][n] = (f32x4){0.f, 0.f, 0.f, 0.f};
        cur = nxt; cA = nA; cB = nB; ++ui;
        if constexpr (ALIGN_EPI) { if (wr == 1) PG8_BAR; }
    }
    PG8_WAIT_V(0);
    if constexpr (!ALIGN_EPI) { if (wr == 0) PG8_BAR; }
    PG8_BAR;
    if constexpr (Epi::AFTER_DRAIN) { E.fused(acc, cur, wr, wc, fr, fq, lds, wid, lane); S.done(cur); }
#undef PG8_SA
#undef PG8_SB
#undef PG8_STAGE
#undef PG8_STAGE_
#undef PG8_IS6
#undef PG8_FRAG
#undef PG8_LDA
#undef PG8_LDB
#undef PG8_MMA
#undef PG8_WAIT_V
#undef PG8_WAIT_L
#undef PG8_BAR
#undef PG8_SCHED
}
}

constexpr int T = 16384, D = 4096;
constexpr int EV_IN = 10240;
constexpr int OD_IN = 18560, OD_INP = 18688;
constexpr int XBC = 10240, SSM_INNER = 8192, NHEAD = 128, NE = 16384, QW = 2048;
constexpr float EPS = 1e-6f;
constexpr int NPHASE = 21, NCU = 256;

constexpr size_t MiB = 1u << 20;
constexpr size_t WS_CTL = 0, CTL_ZERO_BYTES = 1 * MiB;
constexpr size_t WS_KEYS = 2 * MiB;
constexpr size_t WS_WIN0 = 4 * MiB, WS_WOUT0 = 84 * MiB, WS_WQ0 = 116 * MiB, WS_U0 = 132 * MiB, WS_V0 = 196 * MiB;
constexpr size_t WS_WIN1 = 4 * MiB, WS_WOUT1 = 150 * MiB, WS_WQ1 = 214 * MiB, WS_U1 = 230 * MiB, WS_V1 = 294 * MiB;
constexpr size_t WS_HN = 358 * MiB;
constexpr size_t WS_HN8 = 486 * MiB;
constexpr size_t WS_PROJ = 550 * MiB;
constexpr size_t WS_YCAT = 1134 * MiB;
constexpr size_t WS_Q = 1390 * MiB;
constexpr size_t WS_G = 1454 * MiB;
constexpr size_t WS_HB = WS_G + 256 * MiB;
constexpr size_t WS_STATE = WS_G, WS_AEND = WS_G + 512 * MiB;
constexpr size_t WS_END = 2046 * MiB;
constexpr float PEER_U6 = 96.0f, PEER_A6 = 1.25f;
constexpr float OUT1_W6 = 136.0f;
constexpr float PEER_V6 = 4.25f;
constexpr float PEER_US = 64.0f, PEER_GS = 64.0f, PEER_VS = 4.0f;
constexpr int CW_BAR = 4096;

constexpr int LDS_BYTES = 147456, MISC_OFF = LDS_BYTES - 256;

#define GAS __attribute__((address_space(1)))
#define LAS __attribute__((address_space(3)))
typedef unsigned short bf16;
typedef unsigned v4u __attribute__((ext_vector_type(4)));
typedef unsigned v2u __attribute__((ext_vector_type(2)));
typedef float f32x4 __attribute__((ext_vector_type(4)));
typedef float f32x16 __attribute__((ext_vector_type(16)));
typedef short bf16x8 __attribute__((ext_vector_type(8)));
#define LDS_WAIT() asm volatile("s_waitcnt lgkmcnt(0)" ::: "memory")
#define VM_WAIT() asm volatile("s_waitcnt vmcnt(0)" ::: "memory")
__device__ __forceinline__ unsigned pk2(float lo, float hi) { return pg8::cvt_pk_bf16(lo, hi); }
__device__ __forceinline__ float bflo(unsigned w) { return __uint_as_float(w << 16); }
__device__ __forceinline__ float bfhi(unsigned w) { return __uint_as_float(w & 0xffff0000u); }
__device__ __forceinline__ float bf2f(bf16 b) { return __uint_as_float(((unsigned)b) << 16); }
__device__ __forceinline__ void unpack8(const v4u v, float (&f)[8]) { f[0] = bflo(v.x); f[1] = bfhi(v.x); f[2] = bflo(v.y); f[3] = bfhi(v.y); f[4] = bflo(v.z); f[5] = bfhi(v.z); f[6] = bflo(v.w); f[7] = bfhi(v.w); }
__device__ __forceinline__ v4u pack8(const float (&f)[8]) { v4u o; o.x = pk2(f[0], f[1]); o.y = pk2(f[2], f[3]); o.z = pk2(f[4], f[5]); o.w = pk2(f[6], f[7]); return o; }
__device__ __forceinline__ float wave_sum(float v) {
#pragma unroll
    for (int o = 1; o < 64; o <<= 1) v += __shfl_xor(v, o);
    return v;
}
__device__ __forceinline__ float silu_f(float x) { return x * __builtin_amdgcn_rcpf(1.0f + __builtin_amdgcn_exp2f(-1.4426950409f * x)); }
__device__ __forceinline__ float exp_f(float x) { return __builtin_amdgcn_exp2f(1.4426950409f * x); }

#define XB_TMO      128
#define XB_XCNT(j)  (256  + 64 * (j))
#define XB_XSUB(j)  (1280 + 64 * (j))
#define XB_XGEN(j)  (2304 + 64 * (j))
#define XB_TOP      3328
#define XB_TOPGEN   3392
#define XCD_BAR_WORDS 3456
#define XB_SPIN_CAP (1u << 20)
__device__ __forceinline__ unsigned xb_ld(unsigned* p)              { return __hip_atomic_load(p, __ATOMIC_RELAXED, __HIP_MEMORY_SCOPE_AGENT); }
__device__ __forceinline__ unsigned xb_add(unsigned* p, unsigned v) { return __hip_atomic_fetch_add(p, v, __ATOMIC_RELAXED, __HIP_MEMORY_SCOPE_AGENT); }
__device__ __forceinline__ unsigned xb_xcc_id() { return (unsigned)__builtin_amdgcn_s_getreg((3 << 11) | 20) & 0xFu; }
#define XB_SPIN(cond, bar) do { unsigned _sp = 0; while (cond) { __builtin_amdgcn_s_sleep(1); \
    if ((++_sp & 255u) == 0u) { if (xb_ld(&(bar)[XB_TMO])) break; if (_sp > XB_SPIN_CAP) { atomicAdd(&(bar)[XB_TMO], 1u); break; } } } } while (0)
struct XcdBarrier { unsigned* bar; unsigned x; volatile LAS unsigned* st; };
__device__ __forceinline__ XcdBarrier xcd_barrier_post(unsigned* bar, volatile LAS unsigned* st, int tid) {
    XcdBarrier b; b.bar = bar; b.x = xb_xcc_id(); b.st = st;
    if (tid == 0) (void)xb_add(&bar[XB_XCNT(b.x)], 1u);
    return b;
}
__device__ __forceinline__ void xcd_barrier_complete(unsigned* bar, unsigned x, unsigned& nloc, unsigned& nx) {
    const unsigned G = NCU;
    unsigned sum, cnt, mine, sp = 0u;
    for (;;) {
        sum = 0u; cnt = 0u; mine = 0u;
#pragma unroll
        for (unsigned j = 0; j < 16; ++j) { const unsigned c = xb_ld(&bar[XB_XCNT(j)]); sum += c; cnt += (c > 0u) ? 1u : 0u; mine = (j == x) ? c : mine; }
        if (sum == G) break;
        __builtin_amdgcn_s_sleep(1);
        if ((++sp & 255u) == 0u) { if (xb_ld(&bar[XB_TMO])) break; if (sp > XB_SPIN_CAP) { atomicAdd(&bar[XB_TMO], 1u); break; } }
    }
    nloc = mine > 0u ? mine : 1u; nx = cnt > 0u ? cnt : 1u;
}
__device__ __forceinline__ void xcd_barrier(const XcdBarrier& b, int tid) {
    asm volatile("s_waitcnt vmcnt(0)" ::: "memory");
    __syncthreads();
    if (tid == 0) {
        unsigned* bar = b.bar;
        __builtin_amdgcn_s_waitcnt(0);
        unsigned nloc = b.st[0], nx = b.st[1];
        if (nloc == 0u) { xcd_barrier_complete(bar, b.x, nloc, nx); b.st[0] = nloc; b.st[1] = nx; }
        const unsigned old = xb_add(&bar[XB_XSUB(b.x)], 1u);
        const unsigned gen = old / nloc;
        if (old + 1u == (gen + 1u) * nloc) {
            __builtin_amdgcn_fence(__ATOMIC_RELEASE, "agent");
            asm volatile("s_waitcnt vmcnt(0)" ::: "memory");
            const unsigned og = xb_add(&bar[XB_TOP], 1u);
            const unsigned tg = og / nx;
            if (og + 1u == (tg + 1u) * nx) xb_add(&bar[XB_TOPGEN], 1u);
            else XB_SPIN(xb_ld(&bar[XB_TOPGEN]) == tg, bar);
            __builtin_amdgcn_fence(__ATOMIC_ACQUIRE, "agent");
            xb_add(&bar[XB_XGEN(b.x)], 1u);
            asm volatile("s_waitcnt vmcnt(0)" ::: "memory");
        } else {
            XB_SPIN(xb_ld(&bar[XB_XGEN(b.x)]) == gen, bar);
            __builtin_amdgcn_fence(__ATOMIC_ACQUIRE, "agent");
            asm volatile("s_waitcnt vmcnt(0)" ::: "memory");
        }
    }
    __syncthreads();
}

struct Frame { LAS unsigned char* lds; int tid, lane, wave, vcu, G; };

__device__ __forceinline__ int fp6_slot_a(int row) { return row & 127; }
__device__ __forceinline__ int fp6_slot_b(int row) { return (row & 96) + 16 * ((row >> 2) & 1) + 4 * ((row >> 3) & 3) + (row & 3); }
__device__ __forceinline__ size_t tiled_off(int row, int kt, int nt, int cb, bool perm) {
    const int r = row & 127, slot = perm ? fp6_slot_b(r) : r;
    return ((size_t)(row >> 7) * nt + kt) * 16384 + pg8::lds_byte(slot, cb >> 1);
}
__device__ __forceinline__ void transpose_matrix(const Frame& F, const float* W, int K, int N, bf16* WT, int tl  , const float* kscale = nullptr  ) {
    LAS float* scr = (LAS float*)(F.lds + F.wave * 16896);
    const int gw = F.vcu * 8 + F.wave, NGW = F.G * 8, nblk = N / 64, nitems = (K / 64) * nblk;
    const int r4 = F.lane >> 4, c4 = (F.lane & 15) * 4, c = F.lane & 7;
    for (int it = gw; it < nitems; it += NGW) {
        const int kb = it / nblk, nb = it % nblk, k0 = 64 * kb, n0 = 64 * nb;
        f32x4 v[16];
#pragma unroll
        for (int i = 0; i < 16; ++i) v[i] = *(const f32x4*)(W + (size_t)(k0 + 4 * i + r4) * N + n0 + c4);
#pragma unroll
        for (int i = 0; i < 16; ++i) { LAS float* d = scr + (4 * i + r4) * 65 + c4; const float ks_ = kscale ? kscale[k0 + 4 * i + r4] : 1.0f; d[0] = v[i][0] * ks_; d[1] = v[i][1] * ks_; d[2] = v[i][2] * ks_; d[3] = v[i][3] * ks_; }
        LDS_WAIT();
#pragma unroll
        for (int j = 0; j < 8; ++j) { const int n = (F.lane >> 3) + 8 * j; const LAS float* sp = scr + (8 * c) * 65 + n;
            v4u o; o.x = pk2(sp[0 * 65], sp[1 * 65]); o.y = pk2(sp[2 * 65], sp[3 * 65]); o.z = pk2(sp[4 * 65], sp[5 * 65]); o.w = pk2(sp[6 * 65], sp[7 * 65]);
            *(v4u*)((unsigned char*)WT + tiled_off(n0 + n, kb, K / 64, 16 * c, tl == 2)) = o; }
        LDS_WAIT();
    }
}
__device__ __forceinline__ void convert_matrix(const Frame& F, const float* W, bf16* O, size_t n8) {
    const size_t gt = (size_t)F.vcu * 512 + F.tid, NT = (size_t)F.G * 512;
    for (size_t i = gt; i < n8; i += NT) { const f32x4 a = ((const f32x4*)W)[2 * i], b = ((const f32x4*)W)[2 * i + 1];
        v4u o; o.x = pk2(a[0], a[1]); o.y = pk2(a[2], a[3]); o.z = pk2(b[0], b[1]); o.w = pk2(b[2], b[3]); ((v4u*)O)[i] = o; }
}
__device__ __forceinline__ void convert_matrix_fp8(const Frame& F, const float* W, unsigned char* O, size_t n16, float sc) {
    const size_t nblk = n16 / 64;
    const size_t gw = (size_t)F.vcu * 8 + F.wave, NGW = (size_t)F.G * 8;
    for (size_t blk = gw; blk < nblk; blk += NGW) {
        const f32x4* src = (const f32x4*)(W + blk * 1024) + F.lane; int* dst = (int*)(O + blk * 1024) + F.lane;
        f32x4 a[4];
#pragma unroll
        for (int q = 0; q < 4; ++q) a[q] = src[64 * q];
#pragma unroll
        for (int q = 0; q < 4; ++q) { const f32x4 x = a[q] * sc; int w = 0; w = __builtin_amdgcn_cvt_pk_fp8_f32(x[0], x[1], w, false); w = __builtin_amdgcn_cvt_pk_fp8_f32(x[2], x[3], w, true); dst[64 * q] = w; }
    }
}
typedef float f32x16v __attribute__((ext_vector_type(16)));
typedef int i32x6v __attribute__((ext_vector_type(6)));
__device__ __forceinline__ void store_fp6_block(unsigned char* base, size_t row, int slot, int nt  , int blk  , const f32x16v lo, const f32x16v hi) {
    const i32x6v r = __builtin_amdgcn_cvt_scalef32_2xpk16_fp6_f32(lo, hi, 1.0f);
    const int t = blk >> 2, q = blk & 3; unsigned char* p0 = base + (((row >> 7) * (size_t)nt + t) * 128 + slot) * 96;
    v4u a; a.x = (unsigned)r[0]; a.y = (unsigned)r[1]; a.z = (unsigned)r[2]; a.w = (unsigned)r[3]; *(v4u*)(p0 + 16 * q) = a;
    v2u b; b.x = (unsigned)r[4]; b.y = (unsigned)r[5]; *(v2u*)(p0 + 64 + 8 * (q ^ (((slot >> 3) & 1) << 1))) = b;
}
__device__ __forceinline__ void convert_matrix_fp6(const Frame& F, const float* W, unsigned char* O, int K, size_t nblocks, float sc) {
    LAS float* hr = (LAS float*)(F.lds + F.wave * 16896);
    const size_t nstep = nblocks / 64, gw = (size_t)F.vcu * 8 + F.wave, NGW = (size_t)F.G * 8; const int bpr = K / 32;
    for (size_t st = gw; st < nstep; st += NGW) {
        const f32x4* src = (const f32x4*)(W + st * 2048) + F.lane; f32x4 v[8];
#pragma unroll
        for (int q = 0; q < 8; ++q) v[q] = src[64 * q];
#pragma unroll
        for (int q = 0; q < 8; ++q) { const int e = 4 * F.lane + 256 * q; *(LAS f32x4*)(hr + e + 4 * (e >> 5)) = v[q] * sc; }
        LDS_WAIT();
        f32x16v lo, hi; const LAS f32x4* bp = (const LAS f32x4*)(hr + 36 * F.lane);
#pragma unroll
        for (int i = 0; i < 4; ++i) { const f32x4 x = bp[i], z = bp[4 + i]; lo[4 * i] = x[0]; lo[4 * i + 1] = x[1]; lo[4 * i + 2] = x[2]; lo[4 * i + 3] = x[3]; hi[4 * i] = z[0]; hi[4 * i + 1] = z[1]; hi[4 * i + 2] = z[2]; hi[4 * i + 3] = z[3]; }
        const size_t b = st * 64 + F.lane, row = b / bpr; store_fp6_block(O, row, fp6_slot_b((int)(row & 127)), K / 128, (int)(b % bpr), lo, hi);
        LDS_WAIT();
    }
}
__device__ __forceinline__ void transpose_matrix_fp8(const Frame& F, const float* W, int K, int N, unsigned char* WT, float sc, int tl) {
    LAS float* scr = (LAS float*)(F.lds + F.wave * 16896);
    const int gw = F.vcu * 8 + F.wave, NGW = F.G * 8, nblk = N / 32, nitems = (K / 128) * nblk;
    const int r8 = F.lane >> 3, c4 = (F.lane & 7) * 4, c = F.lane & 7;
    for (int it = gw; it < nitems; it += NGW) {
        const int kb = it / nblk, nb = it % nblk, k0 = 128 * kb, n0 = 32 * nb;
        f32x4 v[16];
#pragma unroll
        for (int i = 0; i < 16; ++i) v[i] = *(const f32x4*)(W + (size_t)(k0 + 8 * i + r8) * N + n0 + c4);
#pragma unroll
        for (int i = 0; i < 16; ++i) { LAS float* d = scr + (8 * i + r8) * 33 + c4; d[0] = v[i][0] * sc; d[1] = v[i][1] * sc; d[2] = v[i][2] * sc; d[3] = v[i][3] * sc; }
        LDS_WAIT();
#pragma unroll
        for (int j = 0; j < 4; ++j) { const int n = (F.lane >> 3) + 8 * j; const LAS float* sp = scr + (16 * c) * 33 + n; v4u o;
#pragma unroll
            for (int q = 0; q < 4; ++q) { int w = 0; w = __builtin_amdgcn_cvt_pk_fp8_f32(sp[(4 * q) * 33], sp[(4 * q + 1) * 33], w, false); w = __builtin_amdgcn_cvt_pk_fp8_f32(sp[(4 * q + 2) * 33], sp[(4 * q + 3) * 33], w, true); o[q] = (unsigned)w; }
            *(v4u*)(WT + tiled_off(n0 + n, kb, K / 128, 16 * c, tl == 2)) = o; }
        LDS_WAIT();
    }
}
__device__ __forceinline__ void transpose_matrix_fp6(const Frame& F, const float* W, int K, int N, unsigned char* WT, float sc, bool mixed = false  ) {
    LAS float* scr = (LAS float*)(F.lds + F.wave * 16896);
    const int gw = F.vcu * 8 + F.wave, NGW = F.G * 8, nblk = N / 32, nitems = (K / 128) * nblk;
    const int r8 = F.lane >> 3, c4 = (F.lane & 7) * 4;
    for (int it = gw; it < nitems; it += NGW) {
        const int kb = it / nblk, nb = it % nblk, k0 = 128 * kb, n0 = 32 * nb;
        f32x4 v[16];
#pragma unroll
        for (int i = 0; i < 16; ++i) v[i] = *(const f32x4*)(W + (size_t)(k0 + 8 * i + r8) * N + n0 + c4);
#pragma unroll
        for (int i = 0; i < 16; ++i) { LAS float* d = scr + (8 * i + r8) * 33 + c4; d[0] = v[i][0] * sc; d[1] = v[i][1] * sc; d[2] = v[i][2] * sc; d[3] = v[i][3] * sc; }
        LDS_WAIT();
#pragma unroll
        for (int j = 0; j < 2; ++j) { const int p = F.lane + 64 * j, n = p & 31, blk = p >> 5; const LAS float* sp = scr + (mixed ? 16 * blk : 32 * blk) * 33 + n; f32x16v lo, hi;
#pragma unroll
            for (int i = 0; i < 16; ++i) {
                if (mixed) { const int r0 = 16 * blk + 2 * i; lo[i] = sp[r0 * 33]; hi[i] = sp[(r0 + 1) * 33]; }
                else { lo[i] = sp[i * 33]; hi[i] = sp[(16 + i) * 33]; } }
            store_fp6_block(WT, (size_t)(n0 + n), mixed ? fp6_slot_a(n0 + n) : fp6_slot_b((n0 + n) & 127), K / 128, 4 * kb + blk, lo, hi); }
        LDS_WAIT();
    }
}
__device__ __forceinline__ void zero_bytes(const Frame& F, void* p, size_t n16) {
    const size_t gt = (size_t)F.vcu * 512 + F.tid, NT = (size_t)F.G * 512; const v4u z = {0u, 0u, 0u, 0u};
    for (size_t i = gt; i < n16; i += NT) ((v4u*)p)[i] = z;
}
template <bool SB> __device__ __forceinline__ void rms_load_row(f32x4 (&v)[16], const void* src, int row, int lane) {
    if constexpr (SB) { const v2u* xr = (const v2u*)((const bf16*)src + (size_t)row * D) + lane;
#pragma unroll
        for (int j = 0; j < 16; ++j) { const v2u t = xr[64 * j]; v[j] = (f32x4){bflo(t.x), bfhi(t.x), bflo(t.y), bfhi(t.y)}; } }
    else { const f32x4* xr = (const f32x4*)((const float*)src + (size_t)row * D) + lane;
#pragma unroll
        for (int j = 0; j < 16; ++j) v[j] = xr[64 * j]; }
}
template <bool SB> __device__ __forceinline__ void rms_rows_bf16(const Frame& F, const void* src, const float* g, bf16* dst, unsigned char* dst8 = nullptr, unsigned char* dst6 = nullptr, float sc6 = 1.0f, float* rstd_out = nullptr) {
    const int gw = F.vcu * 8 + F.wave, NGW = F.G * 8;
    f32x4 v[16], nx[16];
    if (gw < T) rms_load_row<SB>(v, src, gw, F.lane);
    for (int m = gw; m < T; m += NGW) {
        const int mn = m + NGW;
        if (mn < T) rms_load_row<SB>(nx, src, mn, F.lane);
        float s = 0.f;
#pragma unroll
        for (int j = 0; j < 16; ++j) s += (v[j].x * v[j].x + v[j].y * v[j].y) + (v[j].z * v[j].z + v[j].w * v[j].w);
        const float rstd = 1.0f / sqrtf(wave_sum(s) * (1.0f / D) + EPS);
        if (rstd_out && F.lane == 0) rstd_out[m] = rstd;
        v2u* o8 = (v2u*)(dst + (size_t)m * D) + F.lane;
#pragma unroll
        for (int j = 0; j < 16; ++j) { const f32x4 gv = ((const f32x4*)g)[F.lane + 64 * j]; const f32x4 y = v[j] * rstd * gv; if (dst) { v2u o; o.x = pk2(y.x, y.y); o.y = pk2(y.z, y.w); o8[64 * j] = o; }
            if (dst8) { int w = 0; w = __builtin_amdgcn_cvt_pk_fp8_f32(y.x, y.y, w, false); w = __builtin_amdgcn_cvt_pk_fp8_f32(y.z, y.w, w, true); ((int*)(dst8 + (size_t)m * D))[F.lane + 64 * j] = w; } }
        if (dst6) {
            LAS float* hr = (LAS float*)(F.lds + F.wave * 16896);
#pragma unroll
            for (int hf = 0; hf < 2; ++hf) {
#pragma unroll
                for (int j8 = 0; j8 < 8; ++j8) { const int j = 8 * hf + j8; const f32x4 gv = ((const f32x4*)g)[F.lane + 64 * j]; const f32x4 y = v[j] * (rstd * sc6) * gv; const int e = 4 * F.lane + 256 * j8;
                    *(LAS f32x4*)(hr + e + 4 * (e >> 5)) = y; }
                LDS_WAIT();
                f32x16v lo, hi; const LAS f32x4* bp = (const LAS f32x4*)(hr + 36 * F.lane);
#pragma unroll
                for (int i = 0; i < 4; ++i) { const f32x4 x = bp[i], z = bp[4 + i]; lo[4 * i] = x[0]; lo[4 * i + 1] = x[1]; lo[4 * i + 2] = x[2]; lo[4 * i + 3] = x[3]; hi[4 * i] = z[0]; hi[4 * i + 1] = z[1]; hi[4 * i + 2] = z[2]; hi[4 * i + 3] = z[3]; }
                store_fp6_block(dst6, (size_t)m, fp6_slot_a(m), D / 128, 64 * hf + F.lane, lo, hi);
                LDS_WAIT(); } }
#pragma unroll
        for (int j = 0; j < 16; ++j) v[j] = nx[j];
    }
}
__device__ __forceinline__ void rms_rows_final(const Frame& F, const bf16* hb, const float* g, float* out) {
    const int gw = F.vcu * 8 + F.wave, NGW = F.G * 8;
    f32x4 v[16], nx[16];
    if (gw < T) rms_load_row<true>(v, hb, gw, F.lane);
    for (int m = gw; m < T; m += NGW) {
        const int mn = m + NGW;
        if (mn < T) rms_load_row<true>(nx, hb, mn, F.lane);
        float s = 0.f;
#pragma unroll
        for (int j = 0; j < 16; ++j) s += (v[j].x * v[j].x + v[j].y * v[j].y) + (v[j].z * v[j].z + v[j].w * v[j].w);
        const float rstd = 1.0f / sqrtf(wave_sum(s) * (1.0f / D) + EPS);
        f32x4* xw = (f32x4*)(out + (size_t)m * D) + F.lane;
#pragma unroll
        for (int j = 0; j < 16; ++j) { const f32x4 gv = ((const f32x4*)g)[F.lane + 64 * j]; xw[64 * j] = v[j] * rstd * gv; }
#pragma unroll
        for (int j = 0; j < 16; ++j) v[j] = nx[j];
    }
}

constexpr int VT_PITCH = 136;
__device__ __forceinline__ void phase_conv_sgu(const Frame& F, const bf16* proj, const float* conv_w, const float* sgu_norm, const float* sgu_w, const float* sgu_b, bf16* ycat) {
    for (int tb = F.vcu; tb < T / 64; tb += F.G) {
        const int c0 = (F.tid & 255) * 8, t0 = tb * 64 + (F.tid >> 8) * 32;
        float w0[8], w1[8], w2[8], p1[8], p2[8];
#pragma unroll
        for (int j = 0; j < 8; ++j) { w0[j] = conv_w[c0 + j]; w1[j] = conv_w[2048 + c0 + j]; w2[j] = conv_w[4096 + c0 + j]; p1[j] = 0.f; p2[j] = 0.f; }
        if (t0 >= 2) {
            float a[8], b[8];
            unpack8(*(const v4u*)(proj + (size_t)(t0 - 2) * EV_IN + 2048 + c0), a); unpack8(*(const v4u*)(proj + (size_t)(t0 - 2) * EV_IN + 4096 + c0), b);
#pragma unroll
            for (int j = 0; j < 8; ++j) p2[j] = a[j] * b[j];
            unpack8(*(const v4u*)(proj + (size_t)(t0 - 1) * EV_IN + 2048 + c0), a); unpack8(*(const v4u*)(proj + (size_t)(t0 - 1) * EV_IN + 4096 + c0), b);
#pragma unroll
            for (int j = 0; j < 8; ++j) p1[j] = a[j] * b[j];
        }
#pragma unroll 4
        for (int i = 0; i < 32; ++i) {
            const bf16* row = proj + (size_t)(t0 + i) * EV_IN + c0;
            float gb[8], gc[8], xt[8], y[8];
            unpack8(*(const v4u*)(row), gb); unpack8(*(const v4u*)(row + 2048), gc); unpack8(*(const v4u*)(row + 4096), xt);
#pragma unroll
            for (int j = 0; j < 8; ++j) { const float pr = gc[j] * xt[j]; y[j] = gb[j] * (w0[j] * p2[j] + w1[j] * p1[j] + w2[j] * pr); p2[j] = p1[j]; p1[j] = pr; }
            *(v4u*)(ycat + (size_t)(t0 + i) * D + c0) = pack8(y);
        }
    }
    LAS float* stats = (LAS float*)F.lds;
    LAS bf16* vT = (LAS bf16*)(F.lds + 1024);
    const int fr = F.lane & 15, fq = F.lane >> 4;
    for (int u = F.vcu; u < 256; u += F.G) {
        const int n = u >> 1, gh = u & 1, t0 = n * 128;
        __syncthreads();
        for (int tt = 0; tt < 16; ++tt) {
            const int tl = F.wave * 16 + tt; const bf16* row = proj + (size_t)(t0 + tl) * EV_IN + 8192;
            float s = 0.f, s2 = 0.f;
#pragma unroll
            for (int j = 0; j < 4; ++j) { float x[8]; unpack8(*(const v4u*)(row + 8 * (F.lane + 64 * j)), x);
#pragma unroll
                for (int k = 0; k < 8; ++k) { s += x[k]; s2 += x[k] * x[k]; } }
            s = wave_sum(s); s2 = wave_sum(s2);
            const float mu = s * (1.0f / 2048.0f), var = fmaxf(s2 * (1.0f / 2048.0f) - mu * mu, 0.f);
            if (F.lane == 0) { stats[2 * tl] = mu; stats[2 * tl + 1] = 1.0f / sqrtf(var + EPS); }
        }
        __syncthreads();
        for (int g8 = 0; g8 < 8; ++g8) {
            const int g = gh * 8 + g8;
            { const int cgrp = F.tid & 15, pl = F.tid >> 4; float ng[8];
#pragma unroll
              for (int j = 0; j < 8; ++j) ng[j] = sgu_norm[g * 128 + cgrp * 8 + j];
#pragma unroll
              for (int pp = 0; pp < 4; ++pp) { const int p = pl + 32 * pp; float x[8]; unpack8(*(const v4u*)(proj + (size_t)(t0 + p) * EV_IN + 8192 + g * 128 + cgrp * 8), x);
                  const float mu = stats[2 * p], rs = stats[2 * p + 1];
#pragma unroll
                  for (int j = 0; j < 8; j += 2) { const unsigned w = pk2((x[j] - mu) * rs * ng[j], (x[j + 1] - mu) * rs * ng[j + 1]);
                      vT[(cgrp * 8 + j) * VT_PITCH + p] = (bf16)(w & 0xffffu); vT[(cgrp * 8 + j + 1) * VT_PITCH + p] = (bf16)(w >> 16); } } }
            __syncthreads();
            f32x4 acc[8];
#pragma unroll
            for (int nt = 0; nt < 8; ++nt) acc[nt] = (f32x4){0.f, 0.f, 0.f, 0.f};
            const int q = F.wave * 16 + fr;
            for (int ks = 0; ks < 4; ++ks) {
                if (32 * ks > F.wave * 16 + 15) break;
                const int p0 = 32 * ks + 8 * fq; const float* wrow = sgu_w + ((size_t)(g * 128 + q)) * 128 + p0;
                const f32x4 wa = *(const f32x4*)wrow, wb = *(const f32x4*)(wrow + 4);
                float wv[8] = {wa[0], wa[1], wa[2], wa[3], wb[0], wb[1], wb[2], wb[3]};
#pragma unroll
                for (int j = 0; j < 8; ++j) wv[j] = (p0 + j <= q) ? wv[j] : 0.f;
                const v4u ap = pack8(wv); const bf16x8 af = __builtin_bit_cast(bf16x8, ap);
#pragma unroll
                for (int nt = 0; nt < 8; ++nt) { const bf16x8 bfr = *(const LAS bf16x8*)(vT + (16 * nt + fr) * VT_PITCH + p0);
                    acc[nt] = __builtin_amdgcn_mfma_f32_16x16x32_bf16(bfr, af, acc[nt], 0, 0, 0); }
            }
            const float bq = sgu_b[g * 128 + q]; const int t = t0 + q;
#pragma unroll
            for (int nt = 0; nt < 8; ++nt) { const int c = g * 128 + 16 * nt + 4 * fq; const v2u uu = *(const v2u*)(proj + (size_t)t * EV_IN + 6144 + c);
                v2u o; o.x = pk2(bflo(uu.x) * (acc[nt][0] + bq), bfhi(uu.x) * (acc[nt][1] + bq)); o.y = pk2(bflo(uu.y) * (acc[nt][2] + bq), bfhi(uu.y) * (acc[nt][3] + bq));
                *(v2u*)(ycat + (size_t)t * D + 2048 + c) = o; }
            __syncthreads();
        }
    }
}

__device__ __forceinline__ unsigned ord_f(float f) { const unsigned u = __float_as_uint(f); return u ^ ((unsigned)((int)u >> 31) | 0x80000000u); }
__device__ __forceinline__ float unord_f(unsigned k) { return __uint_as_float(k ^ ((k & 0x80000000u) ? 0x80000000u : 0xffffffffu)); }
#define CE_(L, a, b) { const unsigned h_ = L[a] > L[b] ? L[a] : L[b]; L[b] = L[a] > L[b] ? L[b] : L[a]; L[a] = h_; }
#define SORT16_DESC(L) do { CE_(L, 0, 1) CE_(L, 2, 3) CE_(L, 0, 2) CE_(L, 1, 3) CE_(L, 1, 2) CE_(L, 4, 5) CE_(L, 6, 7) CE_(L, 4, 6) CE_(L, 5, 7) CE_(L, 5, 6) CE_(L, 0, 4) CE_(L, 2, 6) CE_(L, 2, 4) CE_(L, 1, 5) CE_(L, 3, 7) CE_(L, 3, 5) CE_(L, 1, 2) CE_(L, 3, 4) CE_(L, 5, 6) CE_(L, 8, 9) CE_(L, 10, 11) CE_(L, 8, 10) CE_(L, 9, 11) CE_(L, 9, 10) CE_(L, 12, 13) CE_(L, 14, 15) CE_(L, 12, 14) CE_(L, 13, 15) CE_(L, 13, 14) CE_(L, 8, 12) CE_(L, 10, 14) CE_(L, 10, 12) CE_(L, 9, 13) CE_(L, 11, 15) CE_(L, 11, 13) CE_(L, 9, 10) CE_(L, 11, 12) CE_(L, 13, 14) CE_(L, 0, 8) CE_(L, 4, 12) CE_(L, 4, 8) CE_(L, 2, 10) CE_(L, 6, 14) CE_(L, 6, 10) CE_(L, 2, 4) CE_(L, 6, 8) CE_(L, 10, 12) CE_(L, 1, 9) CE_(L, 5, 13) CE_(L, 5, 9) CE_(L, 3, 11) CE_(L, 7, 15) CE_(L, 7, 11) CE_(L, 3, 5) CE_(L, 7, 9) CE_(L, 11, 13) CE_(L, 1, 2) CE_(L, 3, 4) CE_(L, 5, 6) CE_(L, 7, 8) CE_(L, 9, 10) CE_(L, 11, 12) CE_(L, 13, 14) } while (0)
#define BITONIC16_DESC(L) do { CE_(L, 0, 8) CE_(L, 1, 9) CE_(L, 2, 10) CE_(L, 3, 11) CE_(L, 4, 12) CE_(L, 5, 13) CE_(L, 6, 14) CE_(L, 7, 15) CE_(L, 0, 4) CE_(L, 1, 5) CE_(L, 2, 6) CE_(L, 3, 7) CE_(L, 8, 12) CE_(L, 9, 13) CE_(L, 10, 14) CE_(L, 11, 15) CE_(L, 0, 2) CE_(L, 1, 3) CE_(L, 4, 6) CE_(L, 5, 7) CE_(L, 8, 10) CE_(L, 9, 11) CE_(L, 12, 14) CE_(L, 13, 15) CE_(L, 0, 1) CE_(L, 2, 3) CE_(L, 4, 5) CE_(L, 6, 7) CE_(L, 8, 9) CE_(L, 10, 11) CE_(L, 12, 13) CE_(L, 14, 15) } while (0)
#define MERGE_TOP16(A, B) do { _Pragma("unroll") for (int i_ = 0; i_ < 16; ++i_) A[i_] = A[i_] > B[15 - i_] ? A[i_] : B[15 - i_]; BITONIC16_DESC(A); } while (0)
#define INS16(L, xin) do { unsigned _x = (xin); _Pragma("unroll") for (int _j = 0; _j < 16; ++_j) { const unsigned _h = L[_j] > _x ? L[_j] : _x; _x = L[_j] > _x ? _x : L[_j]; L[_j] = _h; } } while (0)
__device__ __forceinline__ void phase_router(const Frame& F, const bf16* q, const bf16* keys, unsigned char* Gm) {
    LAS v2u* ent = (LAS v2u*)F.lds;
    const int hi = F.lane >> 5, r32 = F.lane & 31, h = F.wave;
    for (int tb = F.vcu; tb < T / 32; tb += F.G) {
        const int t0 = tb * 32;
        { const v4u z = {0u, 0u, 0u, 0u}; unsigned char* zr = Gm + (size_t)(t0 + 4 * F.wave) * NE + 16 * F.lane;
#pragma unroll 1
            for (int k = 0; k < 4; ++k)
#pragma unroll
                for (int j = 0; j < 16; ++j) *(v4u*)(zr + (size_t)k * NE + 1024 * j) = z; }
        unsigned L[2][16];
#pragma unroll
        for (int i = 0; i < 2; ++i) {
            f32x16 acc[4];
#pragma unroll
            for (int mt = 0; mt < 4; ++mt)
#pragma unroll
                for (int r = 0; r < 16; ++r) acc[mt][r] = 0.f;
            const bf16* qrow = q + (size_t)(t0 + r32) * QW + h * 256 + i * 128 + 8 * hi;
            const bf16* krow = keys + ((size_t)((h * 2 + i) * 128 + r32)) * 128 + 8 * hi;
#pragma unroll 2
            for (int ks = 0; ks < 8; ++ks) { const bf16x8 bq = *(const bf16x8*)(qrow + 16 * ks);
#pragma unroll
                for (int mt = 0; mt < 4; ++mt) { const bf16x8 ak = *(const bf16x8*)(krow + mt * 4096 + 16 * ks);
                    acc[mt] = __builtin_amdgcn_mfma_f32_32x32x16_bf16(ak, bq, acc[mt], 0, 0, 0); } }
            const unsigned base = 127u - 4u * (unsigned)hi;
            unsigned G4[4][16];
#pragma unroll
            for (int mt = 0; mt < 4; ++mt)
#pragma unroll
                for (int r = 0; r < 16; ++r) G4[mt][r] = (ord_f(acc[mt][r]) & ~0x7fu) | (base - (unsigned)(32 * mt + 8 * (r >> 2) + (r & 3)));
            SORT16_DESC(G4[0]); SORT16_DESC(G4[1]); SORT16_DESC(G4[2]); SORT16_DESC(G4[3]);
            MERGE_TOP16(G4[0], G4[1]); MERGE_TOP16(G4[2], G4[3]); MERGE_TOP16(G4[0], G4[2]);
            unsigned Pn[16];
#pragma unroll
            for (int j = 0; j < 16; ++j) { L[i][j] = G4[0][j]; Pn[j] = (unsigned)__shfl_xor((int)G4[0][j], 32); }
            MERGE_TOP16(L[i], Pn);
        }
        float v0[16], v1[16];
#pragma unroll
        for (int j = 0; j < 16; ++j) { v0[j] = unord_f(L[0][j] & ~0x7fu); v1[j] = unord_f(L[1][j] & ~0x7fu); }
        unsigned C4[4][16];
        C4[0][0] = (ord_f(v0[0] + v1[0]) & ~0xffu) | 255u;
        C4[0][1] = (ord_f(v0[0] + v1[1]) & ~0xffu) | 254u;
        C4[0][2] = (ord_f(v0[0] + v1[2]) & ~0xffu) | 253u;
        C4[0][3] = (ord_f(v0[0] + v1[3]) & ~0xffu) | 252u;
        C4[0][4] = (ord_f(v0[0] + v1[4]) & ~0xffu) | 251u;
        C4[0][5] = (ord_f(v0[0] + v1[5]) & ~0xffu) | 250u;
        C4[0][6] = (ord_f(v0[0] + v1[6]) & ~0xffu) | 249u;
        C4[0][7] = (ord_f(v0[0] + v1[7]) & ~0xffu) | 248u;
        C4[0][8] = (ord_f(v0[0] + v1[8]) & ~0xffu) | 247u;
        C4[0][9] = (ord_f(v0[0] + v1[9]) & ~0xffu) | 246u;
        C4[0][10] = (ord_f(v0[0] + v1[10]) & ~0xffu) | 245u;
        C4[0][11] = (ord_f(v0[0] + v1[11]) & ~0xffu) | 244u;
        C4[0][12] = (ord_f(v0[0] + v1[12]) & ~0xffu) | 243u;
        C4[0][13] = (ord_f(v0[0] + v1[13]) & ~0xffu) | 242u;
        C4[0][14] = (ord_f(v0[0] + v1[14]) & ~0xffu) | 241u;
        C4[0][15] = (ord_f(v0[0] + v1[15]) & ~0xffu) | 240u;
        C4[1][0] = (ord_f(v0[1] + v1[0]) & ~0xffu) | 239u;
        C4[1][1] = (ord_f(v0[1] + v1[1]) & ~0xffu) | 238u;
        C4[1][2] = (ord_f(v0[1] + v1[2]) & ~0xffu) | 237u;
        C4[1][3] = (ord_f(v0[1] + v1[3]) & ~0xffu) | 236u;
        C4[1][4] = (ord_f(v0[1] + v1[4]) & ~0xffu) | 235u;
        C4[1][5] = (ord_f(v0[1] + v1[5]) & ~0xffu) | 234u;
        C4[1][6] = (ord_f(v0[1] + v1[6]) & ~0xffu) | 233u;
        C4[1][7] = (ord_f(v0[1] + v1[7]) & ~0xffu) | 232u;
        C4[1][8] = (ord_f(v0[2] + v1[0]) & ~0xffu) | 223u;
        C4[1][9] = (ord_f(v0[2] + v1[1]) & ~0xffu) | 222u;
        C4[1][10] = (ord_f(v0[2] + v1[2]) & ~0xffu) | 221u;
        C4[1][11] = (ord_f(v0[2] + v1[3]) & ~0xffu) | 220u;
        C4[1][12] = (ord_f(v0[2] + v1[4]) & ~0xffu) | 219u;
        C4[1][13] = (ord_f(v0[3] + v1[0]) & ~0xffu) | 207u;
        C4[1][14] = (ord_f(v0[3] + v1[1]) & ~0xffu) | 206u;
        C4[1][15] = (ord_f(v0[3] + v1[2]) & ~0xffu) | 205u;
        C4[2][0] = (ord_f(v0[3] + v1[3]) & ~0xffu) | 204u;
        C4[2][1] = (ord_f(v0[4] + v1[0]) & ~0xffu) | 191u;
        C4[2][2] = (ord_f(v0[4] + v1[1]) & ~0xffu) | 190u;
        C4[2][3] = (ord_f(v0[4] + v1[2]) & ~0xffu) | 189u;
        C4[2][4] = (ord_f(v0[5] + v1[0]) & ~0xffu) | 175u;
        C4[2][5] = (ord_f(v0[5] + v1[1]) & ~0xffu) | 174u;
        C4[2][6] = (ord_f(v0[6] + v1[0]) & ~0xffu) | 159u;
        C4[2][7] = (ord_f(v0[6] + v1[1]) & ~0xffu) | 158u;
        C4[2][8] = (ord_f(v0[7] + v1[0]) & ~0xffu) | 143u;
        C4[2][9] = (ord_f(v0[7] + v1[1]) & ~0xffu) | 142u;
        C4[2][10] = (ord_f(v0[8] + v1[0]) & ~0xffu) | 127u;
        C4[2][11] = (ord_f(v0[9] + v1[0]) & ~0xffu) | 111u;
        C4[2][12] = (ord_f(v0[10] + v1[0]) & ~0xffu) | 95u;
        C4[2][13] = (ord_f(v0[11] + v1[0]) & ~0xffu) | 79u;
        C4[2][14] = (ord_f(v0[12] + v1[0]) & ~0xffu) | 63u;
        C4[2][15] = (ord_f(v0[13] + v1[0]) & ~0xffu) | 47u;
        C4[3][0] = (ord_f(v0[14] + v1[0]) & ~0xffu) | 31u;
        C4[3][1] = (ord_f(v0[15] + v1[0]) & ~0xffu) | 15u;
        C4[3][2] = 0u;
        C4[3][3] = 0u;
        C4[3][4] = 0u;
        C4[3][5] = 0u;
        C4[3][6] = 0u;
        C4[3][7] = 0u;
        C4[3][8] = 0u;
        C4[3][9] = 0u;
        C4[3][10] = 0u;
        C4[3][11] = 0u;
        C4[3][12] = 0u;
        C4[3][13] = 0u;
        C4[3][14] = 0u;
        C4[3][15] = 0u;
        SORT16_DESC(C4[0]); SORT16_DESC(C4[1]); SORT16_DESC(C4[2]); SORT16_DESC(C4[3]);
        MERGE_TOP16(C4[0], C4[1]); MERGE_TOP16(C4[2], C4[3]); MERGE_TOP16(C4[0], C4[2]);
        unsigned M2[16];
#pragma unroll
        for (int j = 0; j < 16; ++j) M2[j] = C4[0][j];
        LAS unsigned char* idxrow = (LAS unsigned char*)(F.lds + 32768 + (F.wave * 64 + F.lane) * 32);
        { v4u p0, p1;
#pragma unroll
          for (int q = 0; q < 4; ++q) { p0[q] = (127u - (L[0][4 * q] & 0x7fu)) | ((127u - (L[0][4 * q + 1] & 0x7fu)) << 8) | ((127u - (L[0][4 * q + 2] & 0x7fu)) << 16) | ((127u - (L[0][4 * q + 3] & 0x7fu)) << 24);
                                        p1[q] = (127u - (L[1][4 * q] & 0x7fu)) | ((127u - (L[1][4 * q + 1] & 0x7fu)) << 8) | ((127u - (L[1][4 * q + 2] & 0x7fu)) << 16) | ((127u - (L[1][4 * q + 3] & 0x7fu)) << 24); }
          *(LAS v4u*)idxrow = p0; *(LAS v4u*)(idxrow + 16) = p1; }
        LDS_WAIT();
        float gate[16]; unsigned ex[16]; float gs = 0.f; const float mx = unord_f(M2[0] & ~0xffu);
#pragma unroll
        for (int k = 0; k < 16; ++k) { const unsigned flat = 255u - (M2[k] & 0xffu), a = flat >> 4, b = flat & 15u;
            ex[k] = (unsigned)idxrow[a] * 128u + (unsigned)idxrow[16 + b];
            gate[k] = exp_f(unord_f(M2[k] & ~0xffu) - mx); gs += gate[k]; }
        const float inv = 1.0f / gs;
        __syncthreads();
        if (hi == 0) {
#pragma unroll
            for (int k = 0; k < 16; ++k) { v2u e; e.x = ex[k]; e.y = __float_as_uint(gate[k] * inv); ent[r32 * 128 + h * 16 + k] = e; } }
        __syncthreads();
        LAS unsigned* bm = (LAS unsigned*)(F.lds + 49152 + F.wave * 2048);
        VM_WAIT();
        for (int tk = 0; tk < 4; ++tk) { const int tok = F.wave * 4 + tk; const LAS v2u* er = ent + tok * 128;
            { const v4u z = {0u, 0u, 0u, 0u}; *(LAS v4u*)(bm + 8 * F.lane) = z; *(LAS v4u*)(bm + 8 * F.lane + 4) = z; }
            LDS_WAIT();
            const v2u ea = er[F.lane], eb = er[F.lane + 64];
            const unsigned oa = __hip_atomic_fetch_or(bm + (ea.x >> 5), 1u << (ea.x & 31u), __ATOMIC_RELAXED, __HIP_MEMORY_SCOPE_WORKGROUP);
            const unsigned ob = __hip_atomic_fetch_or(bm + (eb.x >> 5), 1u << (eb.x & 31u), __ATOMIC_RELAXED, __HIP_MEMORY_SCOPE_WORKGROUP);
            const bool dup = (((oa >> (ea.x & 31u)) | (ob >> (eb.x & 31u))) & 1u) != 0u;
            unsigned char* grow = Gm + (size_t)(t0 + tok) * NE;
            if (__builtin_amdgcn_ballot_w64(dup) == 0ull) {
                grow[ea.x] = (unsigned char)(__builtin_amdgcn_cvt_pk_fp8_f32(__uint_as_float(ea.y) * PEER_GS, 0.f, 0, false) & 0xff);
                grow[eb.x] = (unsigned char)(__builtin_amdgcn_cvt_pk_fp8_f32(__uint_as_float(eb.y) * PEER_GS, 0.f, 0, false) & 0xff);
            } else {
                float ta = 0.f, tb2 = 0.f; bool fa = true, fb = true;
                for (int j = 0; j < 128; ++j) { const v2u ej = er[j]; const float gj = __uint_as_float(ej.y);
                    if (ej.x == ea.x) { ta += gj; if (j < F.lane) fa = false; }
                    if (ej.x == eb.x) { tb2 += gj; if (j < F.lane + 64) fb = false; } }
                if (fa) grow[ea.x] = (unsigned char)(__builtin_amdgcn_cvt_pk_fp8_f32(ta * PEER_GS, 0.f, 0, false) & 0xff);
                if (fb) grow[eb.x] = (unsigned char)(__builtin_amdgcn_cvt_pk_fp8_f32(tb2 * PEER_GS, 0.f, 0, false) & 0xff); } }
    }
}

constexpr int XP = 72;
__device__ __forceinline__ float softplus_f(float x) { return fmaxf(x, 0.f) + log1pf(__expf(-fabsf(x))); }
template <int NT> struct ConvIn { v4u raw[NT + 3]; f32x4 w[4][2]; f32x4 b[2]; };
template <int NT> __device__ __forceinline__ void conv_load(ConvIn<NT>& ci, const bf16* col, int t0, const float* cw, const float* cb) {
#pragma unroll
    for (int i = 0; i < NT + 3; ++i) { const int t = t0 - 3 + i; ci.raw[i] = (t >= 0) ? *(const v4u*)(col + (size_t)t * OD_INP) : (v4u){0u, 0u, 0u, 0u}; }
#pragma unroll
    for (int k = 0; k < 4; ++k) { ci.w[k][0] = *(const f32x4*)(cw + k * XBC); ci.w[k][1] = *(const f32x4*)(cw + k * XBC + 4); }
    ci.b[0] = *(const f32x4*)cb; ci.b[1] = *(const f32x4*)(cb + 4);
}
template <int NT> __device__ __forceinline__ void conv_compute(const ConvIn<NT>& ci, float (&y)[NT][8]) {
    float x0[8], x1[8], x2[8], x3[8];
    unpack8(ci.raw[0], x0); unpack8(ci.raw[1], x1); unpack8(ci.raw[2], x2);
#pragma unroll
    for (int i = 0; i < NT; ++i) { unpack8(ci.raw[i + 3], x3);
#pragma unroll
        for (int j = 0; j < 8; ++j) { y[i][j] = silu_f(ci.b[j >> 2][j & 3] + ci.w[0][j >> 2][j & 3] * x0[j] + ci.w[1][j >> 2][j & 3] * x1[j] + ci.w[2][j >> 2][j & 3] * x2[j] + ci.w[3][j >> 2][j & 3] * x3[j]); x0[j] = x1[j]; x1[j] = x2[j]; x2[j] = x3[j]; } }
}
__device__ __forceinline__ void conv_compute_packT(const ConvIn<8>& ci, const float (&wt)[8], v4u (&outp)[8]) {
    float x0[8], x1[8], x2[8], x3[8], ya[8], yb[8];
    unpack8(ci.raw[0], x0); unpack8(ci.raw[1], x1); unpack8(ci.raw[2], x2);
#pragma unroll
    for (int i = 0; i < 8; i += 2) {
        unpack8(ci.raw[i + 3], x3);
#pragma unroll
        for (int j = 0; j < 8; ++j) { ya[j] = wt[i] * silu_f(ci.b[j >> 2][j & 3] + ci.w[0][j >> 2][j & 3] * x0[j] + ci.w[1][j >> 2][j & 3] * x1[j] + ci.w[2][j >> 2][j & 3] * x2[j] + ci.w[3][j >> 2][j & 3] * x3[j]); x0[j] = x1[j]; x1[j] = x2[j]; x2[j] = x3[j]; }
        unpack8(ci.raw[i + 4], x3);
#pragma unroll
        for (int j = 0; j < 8; ++j) { yb[j] = wt[i + 1] * silu_f(ci.b[j >> 2][j & 3] + ci.w[0][j >> 2][j & 3] * x0[j] + ci.w[1][j >> 2][j & 3] * x1[j] + ci.w[2][j >> 2][j & 3] * x2[j] + ci.w[3][j >> 2][j & 3] * x3[j]); x0[j] = x1[j]; x1[j] = x2[j]; x2[j] = x3[j]; }
#pragma unroll
        for (int j = 0; j < 8; ++j) outp[j][i >> 1] = pk2(ya[j], yb[j]);
    }
}
template <int NT> __device__ __forceinline__ void conv_silu_run(const bf16* col, int t0, const float* cw, const float* cb, float (&y)[NT][8]) {
    ConvIn<NT> ci; conv_load<NT>(ci, col, t0, cw, cb); conv_compute<NT>(ci, y);
}
__device__ __forceinline__ float wave_incl_scan(float v, int lane) {
#pragma unroll
    for (int o = 1; o < 64; o <<= 1) { const float t = __shfl_up(v, o); v = (lane >= o) ? v + t : v; }
    return v;
}
__device__ __forceinline__ void dt_acs(const bf16* proj, int t0, int h, const float* dt_bias, const float* a_log, int lane, float& dt, float& acs) {
    dt = softplus_f(bf2f(proj[(size_t)(t0 + lane) * OD_INP + 18432 + h]) + dt_bias[h]);
    acs = wave_incl_scan(dt * (-__expf(a_log[h])), lane);
}
constexpr float SSD_LS = 16.0f;
__device__ __forceinline__ unsigned fp8x4_sat(const f32x4 v, float sc) { int w = 0; w = __builtin_amdgcn_cvt_pk_fp8_f32(__builtin_amdgcn_fmed3f(v[0] * sc, -448.f, 448.f), __builtin_amdgcn_fmed3f(v[1] * sc, -448.f, 448.f), w, false);
    w = __builtin_amdgcn_cvt_pk_fp8_f32(__builtin_amdgcn_fmed3f(v[2] * sc, -448.f, 448.f), __builtin_amdgcn_fmed3f(v[3] * sc, -448.f, 448.f), w, true); return (unsigned)w; }
__device__ __forceinline__ void phase_ssd_s1(const Frame& F, const bf16* proj, const float* conv_w, const float* conv_b, const float* dt_bias, const float* a_log, unsigned char* st, float* aendb) {
    LAS bf16* BT = (LAS bf16*)F.lds;
    LAS bf16* xwT = (LAS bf16*)(F.lds + 18432 + F.wave * 9216);
    LAS float* wgtw = (LAS float*)(F.lds + 18432 + 8 * 9216 + F.wave * 256);
    for (int u = F.vcu; u < (T / 64) * 8; u += F.G) {
        const int c = u >> 3, g = u & 7, t0 = c * 64;
        int lane_o = F.lane; asm volatile("" : "+v"(lane_o));
        const int fr = lane_o & 15, fq = lane_o >> 4, tid_o = F.wave * 64 + lane_o;
        __syncthreads();
        if (tid_o < 256) { const int ng = tid_o & 15, lg = tid_o >> 4, ch = 8192 + g * 128 + ng * 8; float y[4][8];
            conv_silu_run<4>(proj + 8192 + ch, t0 + 4 * lg, conv_w + ch, conv_b + ch, y);
#pragma unroll
            for (int j = 0; j < 8; ++j) { const int n = ng * 8 + j, slot = (n & ~31) + 16 * ((n >> 2) & 1) + 4 * ((n >> 3) & 3) + (n & 3);
                v2u o; o.x = pk2(y[0][j], y[1][j]); o.y = pk2(y[2][j], y[3][j]); *(LAS v2u*)(BT + slot * XP + 4 * lg) = o; } }
        __syncthreads();
#pragma unroll 1
        for (int hh = 0; hh < 2; ++hh) {
            const int h = g * 16 + 2 * F.wave + hh, pg = lane_o & 7, l8 = lane_o >> 3, chx = h * 64 + pg * 8;
            const bf16 dtraw = proj[(size_t)(t0 + lane_o) * OD_INP + 18432 + h]; const float dtb = dt_bias[h], alg = a_log[h];
            ConvIn<8> ci; conv_load<8>(ci, proj + 8192 + chx, t0 + 8 * l8, conv_w + chx, conv_b + chx);
            { const float dt = softplus_f(bf2f(dtraw) + dtb), ac = wave_incl_scan(dt * (-__expf(alg)), lane_o), aend = __shfl(ac, 63);
              wgtw[lane_o] = dt * exp_f(aend - ac);
              if (lane_o == 63) aendb[c * NHEAD + h] = aend; }
            LDS_WAIT();
            { const f32x4 wa = *(const LAS f32x4*)(wgtw + 8 * l8), wb = *(const LAS f32x4*)(wgtw + 8 * l8 + 4); const float wt[8] = {wa[0], wa[1], wa[2], wa[3], wb[0], wb[1], wb[2], wb[3]};
              v4u outp[8]; conv_compute_packT(ci, wt, outp);
#pragma unroll
              for (int j = 0; j < 8; ++j) *(LAS v4u*)(xwT + (pg * 8 + j) * XP + 8 * l8) = outp[j]; }
            LDS_WAIT();
            unsigned char* so = st + ((size_t)(c * NHEAD + h) * 64) * 128;
#pragma unroll
            for (int nh = 0; nh < 2; ++nh) {
                f32x4 acc[4][4];
#pragma unroll
                for (int a = 0; a < 4; ++a)
#pragma unroll
                    for (int b = 0; b < 4; ++b) acc[a][b] = (f32x4){0.f, 0.f, 0.f, 0.f};
#pragma unroll
                for (int ks = 0; ks < 2; ++ks) { bf16x8 af[4];
#pragma unroll
                    for (int pt = 0; pt < 4; ++pt) af[pt] = *(const LAS bf16x8*)(xwT + (16 * pt + fr) * XP + 32 * ks + 8 * fq);
#pragma unroll
                    for (int n4 = 0; n4 < 4; ++n4) { const bf16x8 bfr = *(const LAS bf16x8*)(BT + (16 * (4 * nh + n4) + fr) * XP + 32 * ks + 8 * fq);
#pragma unroll
                        for (int pt = 0; pt < 4; ++pt) acc[pt][n4] = __builtin_amdgcn_mfma_f32_16x16x32_bf16(bfr, af[pt], acc[pt][n4], 0, 0, 0); } }
#pragma unroll
                for (int pt = 0; pt < 4; ++pt)
#pragma unroll
                    for (int k2 = 0; k2 < 2; ++k2) { v2u o; o.x = fp8x4_sat(acc[pt][2 * k2], SSD_LS); o.y = fp8x4_sat(acc[pt][2 * k2 + 1], SSD_LS);
                        *(v2u*)(so + (size_t)(16 * pt + fr) * 128 + 32 * (2 * nh + k2) + 8 * fq) = o; }
            }
            LDS_WAIT();
        }
    }
}
constexpr float SSD_SS = 4.0f;
__device__ __forceinline__ void phase_ssd_scan(const Frame& F, const unsigned char* loc, unsigned char* st, const float* aendb) {
    constexpr size_t CS = (size_t)NHEAD * 64 * 128;
    for (int it = F.vcu * 512 + F.tid; it < NHEAD * 64 * 16; it += F.G * 512) {
        const int h = it >> 10; unsigned char* base = st + (size_t)it * 8; const unsigned char* lbase = loc + (size_t)it * 8;
        float s[8];
#pragma unroll
        for (int j = 0; j < 8; ++j) s[j] = 0.f;
        v2u cur[8], nxt[8]; float dcur[8], dnxt[8];
#pragma unroll
        for (int k = 0; k < 8; ++k) { cur[k] = *(const v2u*)(lbase + (size_t)k * CS); dcur[k] = aendb[k * NHEAD + h]; }
#pragma unroll 1
        for (int c0 = 0; c0 < 256; c0 += 8) {
            if (c0 + 8 < 256) {
#pragma unroll
                for (int k = 0; k < 8; ++k) { nxt[k] = *(const v2u*)(lbase + (size_t)(c0 + 8 + k) * CS); dnxt[k] = aendb[(c0 + 8 + k) * NHEAD + h]; } }
            asm volatile("" ::: "memory");
#pragma unroll
            for (int k = 0; k < 8; ++k) { { const f32x4 sa = {s[0], s[1], s[2], s[3]}, sb = {s[4], s[5], s[6], s[7]}; v2u o; o.x = fp8x4_sat(sa, SSD_SS); o.y = fp8x4_sat(sb, SSD_SS); *(v2u*)(base + (size_t)(c0 + k) * CS) = o; } const float dec = exp_f(dcur[k]); const int w0 = (int)cur[k].x, w1 = (int)cur[k].y;
                const float lv[8] = {__builtin_amdgcn_cvt_f32_fp8(w0, 0), __builtin_amdgcn_cvt_f32_fp8(w0, 1), __builtin_amdgcn_cvt_f32_fp8(w0, 2), __builtin_amdgcn_cvt_f32_fp8(w0, 3),
                                     __builtin_amdgcn_cvt_f32_fp8(w1, 0), __builtin_amdgcn_cvt_f32_fp8(w1, 1), __builtin_amdgcn_cvt_f32_fp8(w1, 2), __builtin_amdgcn_cvt_f32_fp8(w1, 3)};
#pragma unroll
                for (int j = 0; j < 8; ++j) s[j] = s[j] * dec + lv[j] * (1.0f / SSD_LS); }
            asm volatile("" ::: "memory");
#pragma unroll
            for (int k = 0; k < 8; ++k) { cur[k] = nxt[k]; dcur[k] = dnxt[k]; }
        }
    }
}
__device__ __forceinline__ void phase_ssd_out(const Frame& F, const bf16* proj, const float* conv_w, const float* conv_b, const float* dt_bias, const float* a_log, const unsigned char* st, const float* dskip, const float* norm_g, bf16* yn, unsigned char* yn8) {
    constexpr int CP = 136, CBP = 68;
    LAS bf16* Csm = (LAS bf16*)F.lds; LAS bf16* Bsm = (LAS bf16*)(F.lds + 17408); LAS float* cb = (LAS float*)(F.lds + 34816); LAS float* red = (LAS float*)(F.lds + 52224);
    LAS float* acsw = (LAS float*)(F.lds + 54272 + F.wave * 512); LAS float* dtw = acsw + 64;
    LAS bf16* xT = (LAS bf16*)(F.lds + 58368 + F.wave * 9216);
    for (int u = F.vcu; u < (T / 64) * 8; u += F.G) {
        const int c = u >> 3, g = u & 7, t0 = c * 64;
        int lane_o; asm volatile("v_mbcnt_lo_u32_b32 %0, -1, 0\n\tv_mbcnt_hi_u32_b32 %0, -1, %0" : "=&v"(lane_o));
        const int fr = lane_o & 15, fq = lane_o >> 4, tid_o = F.wave * 64 + lane_o;
        __syncthreads();
        { const int tl = tid_o & 255, seg = tl & 15, lg = tl >> 4, isC = tid_o >> 8, ch = 8192 + isC * 1024 + g * 128 + seg * 8; float y[4][8];
          conv_silu_run<4>(proj + 8192 + ch, t0 + 4 * lg, conv_w + ch, conv_b + ch, y);
          LAS bf16* dstm = isC ? Csm : Bsm;
#pragma unroll
          for (int i = 0; i < 4; ++i) *(LAS v4u*)(dstm + (4 * lg + i) * CP + seg * 8) = pack8(y[i]); }
        __syncthreads();
        { const int lt = F.wave >> 1;
#pragma unroll
          for (int si = 0; si < 2; ++si) { const int stt = 2 * (F.wave & 1) + si; f32x4 a = (f32x4){0.f, 0.f, 0.f, 0.f};
#pragma unroll
              for (int ks = 0; ks < 4; ++ks) { const bf16x8 bfr = *(const LAS bf16x8*)(Bsm + (16 * stt + fr) * CP + 32 * ks + 8 * fq), af = *(const LAS bf16x8*)(Csm + (16 * lt + fr) * CP + 32 * ks + 8 * fq);
                  a = __builtin_amdgcn_mfma_f32_16x16x32_bf16(bfr, af, a, 0, 0, 0); }
              *(LAS f32x4*)(cb + (16 * lt + fr) * CBP + 16 * stt + 4 * fq) = a; } }
        __syncthreads();
        float ssq[4] = {0.f, 0.f, 0.f, 0.f};
        v2u ypk[2][4][4];
#pragma unroll
        for (int hh = 0; hh < 2; ++hh) {
            const int h = g * 16 + 2 * F.wave + hh; const unsigned char* sp = st + ((size_t)(c * NHEAD + h) * 64) * 128;
            const int pg = lane_o & 7, l8 = lane_o >> 3, chx = h * 64 + pg * 8;
            const bf16 dtraw = proj[(size_t)(t0 + lane_o) * OD_INP + 18432 + h]; const float dtb = dt_bias[h], alg = a_log[h];
            ConvIn<8> ci; conv_load<8>(ci, proj + 8192 + chx, t0 + 8 * l8, conv_w + chx, conv_b + chx);
            v2u sf[4][4];
            asm volatile("" ::: "memory");
            { const float dt = softplus_f(bf2f(dtraw) + dtb), ac = wave_incl_scan(dt * (-__expf(alg)), lane_o); acsw[lane_o] = ac; dtw[lane_o] = dt; }
            LDS_WAIT();
            { const f32x4 wa = *(const LAS f32x4*)(dtw + 8 * l8), wb = *(const LAS f32x4*)(dtw + 8 * l8 + 4); const float wt[8] = {wa[0], wa[1], wa[2], wa[3], wb[0], wb[1], wb[2], wb[3]};
              v4u outp[8]; conv_compute_packT(ci, wt, outp);
#pragma unroll
              for (int j = 0; j < 8; ++j) *(LAS v4u*)(xT + (pg * 8 + j) * XP + 8 * l8) = outp[j]; }
            asm volatile("" ::: "memory");
#pragma unroll
            for (int ks = 0; ks < 4; ++ks)
#pragma unroll
                for (int pt = 0; pt < 4; ++pt) sf[ks][pt] = *(const v2u*)(sp + (size_t)(16 * pt + fr) * 128 + 32 * ks + 8 * fq);
            LDS_WAIT();
            f32x4 acc[4][4];
#pragma unroll
            for (int a = 0; a < 4; ++a)
#pragma unroll
                for (int b = 0; b < 4; ++b) acc[a][b] = (f32x4){0.f, 0.f, 0.f, 0.f};
#pragma unroll
            for (int ks = 0; ks < 4; ++ks) { bf16x8 sb[4];
#pragma unroll
                for (int pt = 0; pt < 4; ++pt) { const int w0 = (int)sf[ks][pt].x, w1 = (int)sf[ks][pt].y; const pg8::f32x2c a = __builtin_amdgcn_cvt_pk_f32_fp8(w0, false), b = __builtin_amdgcn_cvt_pk_f32_fp8(w0, true), c2 = __builtin_amdgcn_cvt_pk_f32_fp8(w1, false), d = __builtin_amdgcn_cvt_pk_f32_fp8(w1, true);
                    v4u o; o.x = pk2(a[0], a[1]); o.y = pk2(b[0], b[1]); o.z = pk2(c2[0], c2[1]); o.w = pk2(d[0], d[1]); sb[pt] = __builtin_bit_cast(bf16x8, o); }
#pragma unroll
                for (int lt = 0; lt < 4; ++lt) { const bf16x8 cf = *(const LAS bf16x8*)(Csm + (16 * lt + fr) * CP + 32 * ks + 8 * fq);
#pragma unroll
                    for (int pt = 0; pt < 4; ++pt) acc[lt][pt] = __builtin_amdgcn_mfma_f32_16x16x32_bf16(sb[pt], cf, acc[lt][pt], 0, 0, 0); } }
#pragma unroll
            for (int lt = 0; lt < 4; ++lt) { const float el = exp_f(acsw[16 * lt + fr]) * (1.0f / SSD_SS);
#pragma unroll
                for (int pt = 0; pt < 4; ++pt) acc[lt][pt] *= el; }
            const float dh = dskip[h];
#pragma unroll
            for (int ks = 0; ks < 2; ++ks) { bf16x8 xf[4];
#pragma unroll
                for (int pt = 0; pt < 4; ++pt) xf[pt] = *(const LAS bf16x8*)(xT + (16 * pt + fr) * XP + 32 * ks + 8 * fq);
#pragma unroll
                for (int lt = 0; lt < 4; ++lt) { if (32 * ks > 16 * lt + 15) continue;
                    const int l = 16 * lt + fr, s0 = 32 * ks + 8 * fq; const float al = acsw[l], dinv = dh / dtw[l];
                    const f32x4 ca = *(const LAS f32x4*)(cb + l * CBP + s0), cbb = *(const LAS f32x4*)(cb + l * CBP + s0 + 4);
                    const f32x4 sa = *(const LAS f32x4*)(acsw + s0), sb = *(const LAS f32x4*)(acsw + s0 + 4);
                    float mv[8];
#pragma unroll
                    for (int j = 0; j < 4; ++j) { mv[j] = (s0 + j <= l) ? ca[j] * exp_f(al - sa[j]) : 0.f; mv[4 + j] = (s0 + 4 + j <= l) ? cbb[j] * exp_f(al - sb[j]) : 0.f;
                        mv[j] += (s0 + j == l) ? dinv : 0.f; mv[4 + j] += (s0 + 4 + j == l) ? dinv : 0.f; }
                    const v4u mp = pack8(mv); const bf16x8 mf = __builtin_bit_cast(bf16x8, mp);
#pragma unroll
                    for (int pt = 0; pt < 4; ++pt) acc[lt][pt] = __builtin_amdgcn_mfma_f32_16x16x32_bf16(xf[pt], mf, acc[lt][pt], 0, 0, 0); } }
            v2u zreg[4][4];
#pragma unroll
            for (int lt = 0; lt < 4; ++lt)
#pragma unroll
                for (int pt = 0; pt < 4; ++pt) zreg[lt][pt] = *(const v2u*)(proj + (size_t)(t0 + 16 * lt + fr) * OD_INP + h * 64 + 16 * pt + 4 * fq);
#pragma unroll
            for (int lt = 0; lt < 4; ++lt) {
#pragma unroll
                for (int pt = 0; pt < 4; ++pt) { const v2u zv = zreg[lt][pt];
                    const float y0 = acc[lt][pt][0] * silu_f(bflo(zv.x)), y1 = acc[lt][pt][1] * silu_f(bfhi(zv.x)), y2 = acc[lt][pt][2] * silu_f(bflo(zv.y)), y3 = acc[lt][pt][3] * silu_f(bfhi(zv.y));
                    ssq[lt] += (y0 * y0 + y1 * y1) + (y2 * y2 + y3 * y3);
                    ypk[hh][lt][pt].x = pk2(y0, y1); ypk[hh][lt][pt].y = pk2(y2, y3); } }
            LDS_WAIT();
        }
#pragma unroll
        for (int lt = 0; lt < 4; ++lt) { float s = ssq[lt]; s += __shfl_xor(s, 16); s += __shfl_xor(s, 32); if (fq == 0) red[F.wave * 64 + 16 * lt + fr] = s; }
        __syncthreads();
        if (tid_o < 64) { float tot = 0.f;
#pragma unroll
            for (int w = 0; w < 8; ++w) tot += red[w * 64 + tid_o];
            cb[tid_o] = 1.0f / sqrtf(tot * (1.0f / 1024.0f) + EPS); }
        __syncthreads();
#pragma unroll
        for (int hh = 0; hh < 2; ++hh) { const int h = g * 16 + 2 * F.wave + hh;
#pragma unroll
            for (int pt = 0; pt < 4; ++pt) { const int ch = h * 64 + 16 * pt + 4 * fq; const f32x4 ga = *(const f32x4*)(norm_g + ch);
#pragma unroll
                for (int lt = 0; lt < 4; ++lt) { const float rs = cb[16 * lt + fr]; const v2u yv = ypk[hh][lt][pt];
                    int o = 0; o = __builtin_amdgcn_cvt_pk_fp8_f32(bflo(yv.x) * rs * ga[0], bfhi(yv.x) * rs * ga[1], o, false); o = __builtin_amdgcn_cvt_pk_fp8_f32(bflo(yv.y) * rs * ga[2], bfhi(yv.y) * rs * ga[3], o, true);
                    *(unsigned*)(yn8 + tiled_off(t0 + 16 * lt + fr, ch >> 7, SSM_INNER / 128, (ch & 127) & ~15, false) + (ch & 15)) = (unsigned)o; } } }
    }
}

#ifdef DBG_PROBE
__device__ __forceinline__ void dbg_probe_bf16(const Frame& F, const bf16* buf, size_t ld, int width, float* out) {
    const int gw = F.vcu * 8 + F.wave, NGW = F.G * 8;
    for (int m = gw; m < T; m += NGW) for (int c = F.lane; c < D; c += 64) { float s = 0.f; for (int k = c; k < width; k += D) s += bf2f(buf[(size_t)m * ld + k]); out[(size_t)m * D + c] = s; }
}
__device__ __forceinline__ void dbg_probe_f32(const Frame& F, const float* buf, size_t ld, int width, float* out) {
    const int gw = F.vcu * 8 + F.wave, NGW = F.G * 8;
    for (int m = gw; m < T; m += NGW) for (int c = F.lane; c < D; c += 64) { float s = 0.f; for (int k = c; k < width; k += D) s += buf[(size_t)m * ld + k]; out[(size_t)m * D + c] += s; }
}
#endif
struct Params { const float* in[22]; float* out; unsigned char* ws; int ph_lo, ph_hi; };
#ifndef PH_MASK
#define PH_MASK 0xFFFFFFFFu
#endif
typedef const __attribute__((address_space(4))) Params* KArgs;
#ifndef MK_ONE_LAUNCH
#define MK_ONE_LAUNCH 1
#endif
__global__ void __launch_bounds__(512, 2) mega_fwd(Params P) {
    extern __shared__ __attribute__((aligned(16))) unsigned char lds_raw[];
    Frame F0; F0.lds = (LAS unsigned char*)lds_raw; F0.tid = threadIdx.x; F0.lane = F0.tid & 63; F0.wave = __builtin_amdgcn_readfirstlane(F0.tid >> 6);
    F0.G = NCU; { const int bx = blockIdx.x; F0.vcu = (bx % 8) * (NCU / 8) + bx / 8; }
#define FRAME() Frame F = F0; { int l_; asm volatile("v_mbcnt_lo_u32_b32 %0, -1, 0\n\tv_mbcnt_hi_u32_b32 %0, -1, %0" : "=&v"(l_)); F.lane = l_; F.tid = F0.wave * 64 + l_; } \
    KArgs A_ = (KArgs)__builtin_amdgcn_kernarg_segment_ptr(); asm volatile("" : "+s"(A_));     \
    unsigned char* const ws = A_->ws; float* const hres = A_->out; \
    int bid = (int)blockIdx.x; asm volatile("" : "+s"(bid)); F.vcu = (bid % 8) * (NCU / 8) + bid / 8;
    volatile LAS unsigned* MISC = (volatile LAS unsigned*)(F0.lds + MISC_OFF);
    if (F0.tid < 32) MISC[F0.tid] = 0u;
    __syncthreads();
    const int lo = P.ph_lo, hi = P.ph_hi;
    XcdBarrier bar; bar.bar = (unsigned*)(P.ws + WS_CTL) + CW_BAR; bar.x = 0; bar.st = nullptr;
    if (hi - lo > 1) bar = xcd_barrier_post((unsigned*)(P.ws + WS_CTL) + CW_BAR, MISC + 8, F0.tid);
#ifdef DUP_MASK
#define DUPLOOP(k) for (int rp_ = 0; rp_ <= (int)((DUP_MASK >> (k)) & 1u); ++rp_)
#else
#define DUPLOOP(k)
#endif
#define IN(k) (((PH_MASK >> (k)) & 1u) && lo <= (k) && (k) < hi)
#define SEAM(k) do { if (lo <= (k) && (k) + 1 < hi) { FRAME(); xcd_barrier(bar, F.tid); } } while (0)
#define X_IN (A_->in[0])
#define mix_norm (A_->in[1])
#define ffn_norm (A_->in[2])
#define final_norm (A_->in[3])
#define keysb ((bf16*)(ws + WS_KEYS))
#define hn ((bf16*)(ws + WS_HN))
#define proj ((bf16*)(ws + WS_PROJ))
#define ycat ((bf16*)(ws + WS_YCAT))
#define qb ((bf16*)(ws + WS_Q))
#define Gm (ws + WS_G)
#define hn8 (ws + WS_HN8)
#define aendb ((float*)(ws + WS_AEND))
#define hb ((bf16*)(ws + WS_HB))
#define rstdb ((float*)(ws + WS_HB + 128 * MiB))
#define state ((bf16*)(ws + WS_STATE))

    if (IN(0)) DUPLOOP(0) { FRAME();
        transpose_matrix(F, A_->in[4], D, EV_IN, (bf16*)(ws + WS_WIN0), 2);
        transpose_matrix(F, A_->in[9], D, D, (bf16*)(ws + WS_WOUT0), 1);
        transpose_matrix(F, A_->in[18], D, QW, (bf16*)(ws + WS_WQ0), 2, ffn_norm);
        transpose_matrix_fp6(F, A_->in[21], NE, D, ws + WS_V0, PEER_V6, true);
        convert_matrix_fp6(F, A_->in[20], ws + WS_U0, D, (size_t)NE * D / 32, PEER_U6);
        convert_matrix(F, A_->in[19], keysb, (size_t)2 * 8 * 2 * 128 * 128 / 8);
        rms_rows_bf16<false>(F, X_IN, mix_norm, hn);
    }
    SEAM(0);
    if (IN(1)) DUPLOOP(1) { FRAME(); { pg8::Gemm g{hn, (bf16*)(ws + WS_WIN0), T, EV_IN, D}; pg8::StaticOrder S; S.init(T, EV_IN, F.G, bid); pg8::EpiBf16G E{proj, EV_IN, 24, 1.0f};
        pg8::gemm_phase<pg8::EpiBf16G, pg8::StaticOrder, true, true, false, 0, false, true>(F.lds, g, S, E, F.tid); } }
    SEAM(1);
    if (IN(2)) DUPLOOP(2) { FRAME(); phase_conv_sgu(F, proj, A_->in[5], A_->in[6], A_->in[7], A_->in[8], ycat); }
    SEAM(2);
    if (IN(3)) DUPLOOP(3) { FRAME(); { pg8::Gemm g{ycat, (bf16*)(ws + WS_WOUT0), T, D, D}; pg8::StaticOrder S; S.init(T, D, F.G, bid); pg8::EpiRes<false, true> E{X_IN, hb, D, 1.0f};
        pg8::gemm_phase<pg8::EpiRes<false, true>, pg8::StaticOrder, true, true, false, 0, false, true>(F.lds, g, S, E, F.tid); } }
    SEAM(3);
    if (IN(4)) DUPLOOP(4) { FRAME(); rms_rows_bf16<true>(F, hb, ffn_norm, nullptr, nullptr, hn8, PEER_A6, rstdb); }
    SEAM(4);
    if (IN(5)) DUPLOOP(5) { FRAME(); { pg8::Gemm g{hb, (bf16*)(ws + WS_WQ0), T, QW, D}; pg8::StaticOrder S; S.init(T, QW, F.G, bid); pg8::EpiBf16G E{qb, QW, 1 << 30, 1.0f, rstdb};
        pg8::gemm_phase<pg8::EpiBf16G, pg8::StaticOrder, true, true, false, 0, false, true>(F.lds, g, S, E, F.tid); } }
    SEAM(5);
    if (IN(6)) DUPLOOP(6) { FRAME(); phase_router(F, qb, keysb, Gm); }
    SEAM(6);
    if (IN(7)) DUPLOOP(7) { FRAME(); { pg8::Gemm g{(const bf16*)hn8, (const bf16*)(ws + WS_U0), T, NE, D / 2}; pg8::StaticOrder S; S.init(T, NE, F.G, bid); pg8::EpiPeerU8 E{Gm, NE, 1.0f / (PEER_U6 * PEER_A6)};
        pg8::gemm_phase<pg8::EpiPeerU8, pg8::StaticOrder, true, true, true, 2>(F.lds, g, S, E, F.tid); } }
    SEAM(7);
    if (IN(8)) DUPLOOP(8) { FRAME(); { pg8::Gemm g{(const bf16*)Gm, (const bf16*)(ws + WS_V0), T, D, NE / 2}; pg8::StaticOrder S; S.init(T, D, F.G, bid); pg8::EpiRes<true, true> E{hb, hb, D, 1.0f / (PEER_GS * PEER_V6)};
        pg8::gemm_phase<pg8::EpiRes<true, true>, pg8::StaticOrder, true, true, true, 3>(F.lds, g, S, E, F.tid); } }
    SEAM(8);
    if (IN(9)) DUPLOOP(9) { FRAME();
        transpose_matrix_fp6(F, A_->in[10], D, OD_IN, ws + WS_WIN1, PEER_U6);
        zero_bytes(F, ws + WS_WIN1 + (size_t)OD_IN * (D * 3 / 4), (size_t)(OD_INP - OD_IN) * (D * 3 / 4) / 16);
        transpose_matrix_fp6(F, A_->in[17], SSM_INNER, D, ws + WS_WOUT1, OUT1_W6, true);
        transpose_matrix(F, A_->in[18] + (size_t)D * QW, D, QW, (bf16*)(ws + WS_WQ1), 2, ffn_norm + D);
        transpose_matrix_fp6(F, A_->in[21] + (size_t)NE * D, NE, D, ws + WS_V1, PEER_V6, true);
        convert_matrix_fp6(F, A_->in[20] + (size_t)NE * D, ws + WS_U1, D, (size_t)NE * D / 32, PEER_U6);
        rms_rows_bf16<true>(F, hb, mix_norm + D, nullptr, nullptr, hn8, PEER_A6);
    }
    SEAM(9);
    if (IN(10)) DUPLOOP(10) { FRAME(); { pg8::Gemm g{(const bf16*)hn8, (const bf16*)(ws + WS_WIN1), T, OD_INP, D / 2}; pg8::StaticOrder S; S.init(T, OD_INP, F.G, bid); pg8::EpiBf16G E{proj, OD_INP, 1 << 30, 1.0f / (PEER_U6 * PEER_A6)};
        pg8::gemm_phase<pg8::EpiBf16G, pg8::StaticOrder, true, true, true, 2>(F.lds, g, S, E, F.tid); } }
    SEAM(10);
    if (IN(11)) DUPLOOP(11) { FRAME(); phase_ssd_s1(F, proj, A_->in[11], A_->in[12], A_->in[13], A_->in[14], (unsigned char*)ycat, aendb); }
    SEAM(11);
    if (IN(12)) DUPLOOP(12) { FRAME(); phase_ssd_scan(F, (const unsigned char*)ycat, (unsigned char*)state, aendb); }
    SEAM(12);
    if (IN(13)) DUPLOOP(13) { FRAME(); phase_ssd_out(F, proj, A_->in[11], A_->in[12], A_->in[13], A_->in[14], (const unsigned char*)state, A_->in[15], A_->in[16], ycat, (unsigned char*)hn); }
    SEAM(13);
    if (IN(14)) { FRAME(); { pg8::Gemm g{(const bf16*)hn, (const bf16*)(ws + WS_WOUT1), T, D, SSM_INNER / 2}; pg8::StaticOrder S; S.init(T, D, F.G, bid); pg8::EpiRes<true, true> E{hb, hb, D, 1.0f / OUT1_W6};
        pg8::gemm_phase<pg8::EpiRes<true, true>, pg8::StaticOrder, true, true, true, 3, true, false>(F.lds, g, S, E, F.tid); } }
    SEAM(14);
    if (IN(15)) DUPLOOP(15) { FRAME(); { rms_rows_bf16<true>(F, hb, ffn_norm + D, nullptr, nullptr, hn8, PEER_A6, rstdb); } }
    SEAM(15);
    if (IN(16)) DUPLOOP(16) { FRAME(); { pg8::Gemm g{hb, (bf16*)(ws + WS_WQ1), T, QW, D}; pg8::StaticOrder S; S.init(T, QW, F.G, bid); pg8::EpiBf16G E{qb, QW, 1 << 30, 1.0f, rstdb};
        pg8::gemm_phase<pg8::EpiBf16G, pg8::StaticOrder, true, true, false, 0, false, true>(F.lds, g, S, E, F.tid); } }
    SEAM(16);
    if (IN(17)) DUPLOOP(17) { FRAME(); phase_router(F, qb, keysb + (size_t)8 * 2 * 128 * 128, Gm); }
    SEAM(17);
    if (IN(18)) DUPLOOP(18) { FRAME(); { pg8::Gemm g{(const bf16*)hn8, (const bf16*)(ws + WS_U1), T, NE, D / 2}; pg8::StaticOrder S; S.init(T, NE, F.G, bid); pg8::EpiPeerU8 E{Gm, NE, 1.0f / (PEER_U6 * PEER_A6)};
        pg8::gemm_phase<pg8::EpiPeerU8, pg8::StaticOrder, true, true, true, 2>(F.lds, g, S, E, F.tid); } }
    SEAM(18);
    if (IN(19)) DUPLOOP(19) { FRAME(); { pg8::Gemm g{(const bf16*)Gm, (const bf16*)(ws + WS_V1), T, D, NE / 2}; pg8::StaticOrder S; S.init(T, D, F.G, bid); pg8::EpiRes<true, true> E{hb, hb, D, 1.0f / (PEER_GS * PEER_V6)};
        pg8::gemm_phase<pg8::EpiRes<true, true>, pg8::StaticOrder, true, true, true, 3>(F.lds, g, S, E, F.tid); } }
    SEAM(19);
#ifdef DBG_PROBE
    if (lo == 20) { FRAME();
        if (DBG_PROBE == 3) dbg_probe_bf16(F, state, D, D, hres);
        if (DBG_PROBE == 4) dbg_probe_bf16(F, ycat, SSM_INNER, 2048, hres);
        if (DBG_PROBE == 5) dbg_probe_bf16(F, proj, OD_INP, OD_IN, hres);
    }
#endif
    if (IN(20)) DUPLOOP(20) { FRAME(); rms_rows_final(F, hb, final_norm, hres); }
#undef IN
#undef SEAM
#undef X_IN
#undef mix_norm
#undef ffn_norm
#undef final_norm
#undef keysb
#undef hn
#undef proj
#undef ycat
#undef qb
#undef Gm
#undef hn8
#undef aendb
#undef hb
#undef rstdb
#undef state
}
__global__ void fill_zero(float* o, int n) { for (int i = blockIdx.x * blockDim.x + threadIdx.x; i < n; i += gridDim.x * blockDim.x) o[i] = 0.f; }

extern "C" void kernel_launch(void* const* d_in, const int* in_sizes, int n_in, void* d_out, int out_size, void* d_ws, size_t ws_size, hipStream_t stream) {
    static int grid = 0;
    if (grid == 0) {
        if (n_in != 22 || out_size != T * D || ws_size < WS_END) { fprintf(stderr, "kernel_launch: unexpected shapes (n_in %d, out %d, ws %zu < %zu)\n", n_in, out_size, ws_size, (size_t)WS_END); grid = -1; }
        else {
            int dev = 0, cus = 0, per_cu = 0;
            if (hipGetDevice(&dev) != hipSuccess || hipDeviceGetAttribute(&cus, hipDeviceAttributeMultiprocessorCount, dev) != hipSuccess) grid = -1;
            else if (hipFuncSetAttribute((const void*)mega_fwd, hipFuncAttributeMaxDynamicSharedMemorySize, LDS_BYTES) != hipSuccess) { fprintf(stderr, "kernel_launch: hipFuncSetAttribute failed\n"); grid = -1; }
            else {
                if (hipOccupancyMaxActiveBlocksPerMultiprocessor(&per_cu, (const void*)mega_fwd, 512, LDS_BYTES) != hipSuccess || per_cu < 1) fprintf(stderr, "kernel_launch: occupancy query reports %d blocks/CU\n", per_cu);
                (void)hipGetLastError();
                grid = (cus == NCU) ? cus : -1;
            }
        }
    }
    if (grid < 0) { hipLaunchKernelGGL(fill_zero, dim3(1024), dim3(256), 0, stream, (float*)d_out, out_size); return; }
    if (hipMemsetAsync((char*)d_ws + WS_CTL, 0, CTL_ZERO_BYTES, stream) != hipSuccess) return;
    Params p{};
    for (int i = 0; i < 22; ++i) p.in[i] = (const float*)d_in[i];
    p.out = (float*)d_out; p.ws = (unsigned char*)d_ws;
#if MK_ONE_LAUNCH
    p.ph_lo = 0; p.ph_hi = NPHASE;
    hipLaunchKernelGGL(mega_fwd, dim3(grid), dim3(512), LDS_BYTES, stream, p);
#else
    for (int k = 0; k < NPHASE; ++k) { p.ph_lo = k; p.ph_hi = k + 1; hipLaunchKernelGGL(mega_fwd, dim3(grid), dim3(512), LDS_BYTES, stream, p); }
#endif
}
```

```cpp
#include <hip/hip_runtime.h>
#include <cstdio>
#include <cstdint>
#define MK_ONE_LAUNCH 1
namespace pg8 {
#define PG8_LAS __attribute__((address_space(3)))
typedef unsigned short bf16_t;
typedef short bf16x8 __attribute__((ext_vector_type(8)));
typedef float f32x4 __attribute__((ext_vector_type(4)));
typedef unsigned u32x4 __attribute__((ext_vector_type(4)));
constexpr int BM = 256, BK = 64, HALF = 128, HTB = HALF * BK * 2  , STAGE_BYTES = 8 * HTB, NXCD = 8, WGM = 8;

__host__ __device__ __forceinline__ int lds_byte(int r, int c) { const int st = (r >> 4) * 2 + (c >> 5), rr = r & 15, cc = c & 31, ob = rr * 64 + cc * 2; return st * 1024 + (ob ^ (((ob >> 9) & 1) << 5)); }
__host__ __device__ __forceinline__ void stage_rc(int b, int& R, int& C) { const int st = b / 1024, sb = b % 1024, swz = sb ^ (((sb >> 9) & 1) << 5); R = (st >> 1) * 16 + swz / 64; C = (st & 1) * 32 + (swz % 64) / 2; }
__host__ __device__ __forceinline__ int perm32(int rho) { const int n = rho >> 4, i = rho & 15; return 8 * (i >> 2) + 4 * n + (i & 3); }

struct Unit { int pm, pn; };
struct Gemm { const bf16_t* A; const bf16_t* Bt; int M, N, K; };

struct StaticOrder {
    int nM, nN, nwg, G, c, wgm = WGM;
    __host__ __device__ void init(int M, int N, int G_, int c_) { nM = M / BM; nN = N / BM; nwg = nM * nN; G = G_; c = c_; }
    __host__ __device__ bool next(int i, Unit& u) const {
        const long L = (long)i * G + c; if (L >= nwg) return false;
        int wgid = (int)L; { const int q = nwg / NXCD, r = nwg % NXCD, xcd = wgid % NXCD, off = wgid / NXCD; wgid = (xcd < r ? xcd * (q + 1) : r * (q + 1) + (xcd - r) * q) + off; }
        const int nig = wgm * nN, gid = wgid / nig, fm = gid * wgm, gsz = (nM - fm) < wgm ? (nM - fm) : wgm;
        u.pm = fm + ((wgid % nig) % gsz); u.pn = (wgid % nig) / gsz; return true;
    }
    __device__ __forceinline__ void a_ready(const Unit&) const {}
    __device__ __forceinline__ void done(const Unit&) const {}
};

typedef float f32x2c __attribute__((ext_vector_type(2))); typedef __bf16 bf16x2c __attribute__((ext_vector_type(2)));
__device__ __forceinline__ unsigned cvt_pk_bf16(float lo, float hi) { const f32x2c v = {lo, hi}; return __builtin_bit_cast(unsigned, __builtin_convertvector(v, bf16x2c)); }
typedef unsigned u32x2 __attribute__((ext_vector_type(2)));
typedef int i32x4 __attribute__((ext_vector_type(4)));
typedef int i32x8 __attribute__((ext_vector_type(8)));
typedef int i32x16 __attribute__((ext_vector_type(16)));
typedef int i32x32 __attribute__((ext_vector_type(32)));
__device__ __forceinline__ float gelu_tanh(float x) {
    const float u = x * (1.0f + 0.044715f * x * x);
    const float e = __builtin_amdgcn_exp2f(-2.302208198f * u);
    return x * __builtin_amdgcn_rcpf(1.0f + e);
}
struct EpiBf16G {
    static constexpr bool PERM = true, AFTER_DRAIN = false;
    bf16_t* O; int ldc; int gelu_from; float scale; const float* rs = nullptr;
    __device__ __forceinline__ void operator()(const f32x4 (&acc)[2][2][4][2], const Unit& u, int wr, int wc, int fr, int fq) const {
        const int row0 = u.pm * BM + wr * 64 + fr, col0 = u.pn * BM + wc * 32 + 8 * fq;
        const bool act = u.pn >= gelu_from;
#pragma unroll
        for (int ai = 0; ai < 2; ++ai)
#pragma unroll
            for (int m = 0; m < 4; ++m) { bf16_t* rowp = O + (size_t)(row0 + ai * HALF + m * 16) * ldc + col0; const float sc_ = rs ? scale * rs[row0 + ai * HALF + m * 16] : scale;
#pragma unroll
                for (int bj = 0; bj < 2; ++bj) { f32x4 v0 = acc[ai][bj][m][0] * sc_, v1 = acc[ai][bj][m][1] * sc_;
                    if (act) {
#pragma unroll
                        for (int j = 0; j < 4; ++j) { v0[j] = gelu_tanh(v0[j]); v1[j] = gelu_tanh(v1[j]); } }
                    u32x4 w; w.x = cvt_pk_bf16(v0[0], v0[1]); w.y = cvt_pk_bf16(v0[2], v0[3]); w.z = cvt_pk_bf16(v1[0], v1[1]); w.w = cvt_pk_bf16(v1[2], v1[3]);
                    *(u32x4*)(rowp + bj * HALF) = w; } }
    }
};
struct EpiResF32 {
    static constexpr bool PERM = false, AFTER_DRAIN = false;
    const float* base; float* out; int ldc; float scale;
    __device__ __forceinline__ void operator()(const f32x4 (&acc)[2][2][4][2], const Unit& u, int wr, int wc, int fr, int fq) const {
        const int row0 = u.pm * BM + wr * 64 + fr, col0 = u.pn * BM + wc * 32 + 4 * fq;
#pragma unroll
        for (int ai = 0; ai < 2; ++ai)
#pragma unroll
            for (int m = 0; m < 4; ++m) { const size_t off = (size_t)(row0 + ai * HALF + m * 16) * ldc + col0;
                f32x4 bs[2][2];
#pragma unroll
                for (int bj = 0; bj < 2; ++bj)
#pragma unroll
                    for (int n = 0; n < 2; ++n) bs[bj][n] = *(const f32x4*)(base + off + bj * HALF + n * 16);
#pragma unroll
                for (int bj = 0; bj < 2; ++bj)
#pragma unroll
                    for (int n = 0; n < 2; ++n) *(f32x4*)(out + off + bj * HALF + n * 16) = bs[bj][n] + acc[ai][bj][m][n] * scale;
                asm volatile("" ::: "memory"); }
    }
};
template <bool BB, bool OB> struct EpiRes {
    static constexpr bool PERM = false, AFTER_DRAIN = false;
    const void* base; void* out; int ldc; float scale;
    __device__ __forceinline__ void operator()(const f32x4 (&acc)[2][2][4][2], const Unit& u, int wr, int wc, int fr, int fq) const {
        const int row0 = u.pm * BM + wr * 64 + fr, col0 = u.pn * BM + wc * 32 + 4 * fq;
#pragma unroll
        for (int ai = 0; ai < 2; ++ai)
#pragma unroll
            for (int m = 0; m < 4; ++m) { const size_t off = (size_t)(row0 + ai * HALF + m * 16) * ldc + col0;
                f32x4 bs[2][2];
#pragma unroll
                for (int bj = 0; bj < 2; ++bj)
#pragma unroll
                    for (int n = 0; n < 2; ++n) {
                        if constexpr (BB) { const u32x2 t = *(const u32x2*)((const bf16_t*)base + off + bj * HALF + n * 16);
                            bs[bj][n] = (f32x4){__uint_as_float(t.x << 16), __uint_as_float(t.x & 0xffff0000u), __uint_as_float(t.y << 16), __uint_as_float(t.y & 0xffff0000u)}; }
                        else bs[bj][n] = *(const f32x4*)((const float*)base + off + bj * HALF + n * 16); }
#pragma unroll
                for (int bj = 0; bj < 2; ++bj)
#pragma unroll
                    for (int n = 0; n < 2; ++n) { const f32x4 r = bs[bj][n] + acc[ai][bj][m][n] * scale;
                        if constexpr (OB) { u32x2 w; w.x = cvt_pk_bf16(r[0], r[1]); w.y = cvt_pk_bf16(r[2], r[3]); *(u32x2*)((bf16_t*)out + off + bj * HALF + n * 16) = w; }
                        else *(f32x4*)((float*)out + off + bj * HALF + n * 16) = r; }
                asm volatile("" ::: "memory"); }
    }
};
struct EpiPeerU {
    static constexpr bool PERM = true, AFTER_DRAIN = false;
    bf16_t* Gm; int ldc;
    __device__ __forceinline__ void operator()(const f32x4 (&acc)[2][2][4][2], const Unit& u, int wr, int wc, int fr, int fq) const {
        const int row0 = u.pm * BM + wr * 64 + fr, col0 = u.pn * BM + wc * 32 + 8 * fq;
#pragma unroll
        for (int ai = 0; ai < 2; ++ai) {
            u32x4 gv[4][2];
#pragma unroll
            for (int m = 0; m < 4; ++m)
#pragma unroll
                for (int bj = 0; bj < 2; ++bj) gv[m][bj] = *(const u32x4*)(Gm + (size_t)(row0 + ai * HALF + m * 16) * ldc + col0 + bj * HALF);
#pragma unroll
            for (int m = 0; m < 4; ++m)
#pragma unroll
                for (int bj = 0; bj < 2; ++bj) { const u32x4 g = gv[m][bj];
                    if ((g.x | g.y | g.z | g.w) != 0u) { const f32x4 v0 = acc[ai][bj][m][0], v1 = acc[ai][bj][m][1]; u32x4 w;
                        w.x = cvt_pk_bf16(__uint_as_float(g.x << 16) * gelu_tanh(v0[0]), __uint_as_float(g.x & 0xffff0000u) * gelu_tanh(v0[1]));
                        w.y = cvt_pk_bf16(__uint_as_float(g.y << 16) * gelu_tanh(v0[2]), __uint_as_float(g.y & 0xffff0000u) * gelu_tanh(v0[3]));
                        w.z = cvt_pk_bf16(__uint_as_float(g.z << 16) * gelu_tanh(v1[0]), __uint_as_float(g.z & 0xffff0000u) * gelu_tanh(v1[1]));
                        w.w = cvt_pk_bf16(__uint_as_float(g.w << 16) * gelu_tanh(v1[2]), __uint_as_float(g.w & 0xffff0000u) * gelu_tanh(v1[3]));
                        *(u32x4*)(Gm + (size_t)(row0 + ai * HALF + m * 16) * ldc + col0 + bj * HALF) = w; } }
        }
    }
};

struct EpiPeerU8 {
    static constexpr bool PERM = true, AFTER_DRAIN = false;
    unsigned char* Gm; int ldc; float sc;
    __device__ __forceinline__ void operator()(const f32x4 (&acc)[2][2][4][2], const Unit& u, int wr, int wc, int fr, int fq) const {
        const int row0 = u.pm * BM + wr * 64 + fr, col0 = u.pn * BM + wc * 32 + 8 * fq;
#pragma unroll
        for (int ai = 0; ai < 2; ++ai)
#pragma unroll
            for (int m = 0; m < 4; ++m) { u32x2 gv[2];
#pragma unroll
                for (int bj = 0; bj < 2; ++bj) gv[bj] = *(const u32x2*)(Gm + (size_t)(row0 + ai * HALF + m * 16) * ldc + col0 + bj * HALF);
#pragma unroll
                for (int bj = 0; bj < 2; ++bj) { const u32x2 g = gv[bj];
                    if (__builtin_amdgcn_ballot_w64((g.x | g.y) != 0u) != 0ull) { unsigned w0 = 0u, w1 = 0u;
#define PEER_POS(GW, AV, K, WOUT) if (__builtin_amdgcn_ballot_w64((((GW) >> (8 * (K))) & 0xffu) != 0u) != 0ull) { const float p_ = __builtin_amdgcn_cvt_f32_fp8((int)(GW), K) * gelu_tanh((AV)[K] * sc); \
                            WOUT |= ((unsigned)__builtin_amdgcn_cvt_pk_fp8_f32(p_, 0.f, 0, false) & 0xffu) << (8 * (K)); }
                        PEER_POS(g.x, acc[ai][bj][m][0], 0, w0) PEER_POS(g.x, acc[ai][bj][m][0], 1, w0) PEER_POS(g.x, acc[ai][bj][m][0], 2, w0) PEER_POS(g.x, acc[ai][bj][m][0], 3, w0)
                        PEER_POS(g.y, acc[ai][bj][m][1], 0, w1) PEER_POS(g.y, acc[ai][bj][m][1], 1, w1) PEER_POS(g.y, acc[ai][bj][m][1], 2, w1) PEER_POS(g.y, acc[ai][bj][m][1], 3, w1)
#undef PEER_POS
                        if ((g.x | g.y) != 0u) { u32x2 w; w.x = w0; w.y = w1; *(u32x2*)(Gm + (size_t)(row0 + ai * HALF + m * 16) * ldc + col0 + bj * HALF) = w; } } }
                asm volatile("" ::: "memory"); }
    }
};
#define PG8_GAS __attribute__((address_space(1)))
__device__ __forceinline__ bf16x8 frag_lo8(const PG8_LAS unsigned char* p) { const u32x2 t = *(const volatile PG8_LAS u32x2*)p; const u32x4 r = __builtin_shufflevector(t, t, 0, 1, -1, -1); return __builtin_bit_cast(bf16x8, r); }
template <class Epi, class Sched, bool ALIGN_EPI = false, bool SP2 = false, bool FP8 = false, int FMT = 0, bool TLA = false, bool TLB = false>
__device__ __forceinline__ void gemm_phase(PG8_LAS unsigned char* lds, const Gemm g, const Sched& S, const Epi& E, const int tid) {
    const int wid = __builtin_amdgcn_readfirstlane(tid >> 6), lane = tid & 63, wr = wid >> 2, wc = wid & 3, fr = lane & 15, fq = lane >> 4;
    constexpr bool F6D = FP8 && FMT == 2;
    constexpr bool F6A = F6D, F6B = FP8 && (FMT == 2 || FMT == 3);
    const int K = g.K, nt = K / BK, PITCH = K * 2;
    unsigned voffA[2], voffB[2];
#pragma unroll
    for (int i = 0; i < 2; ++i) {
        const unsigned v6 = (unsigned)(i == 0 ? wid * 1024 + 16 * lane : 8192 + wid * 512 + 16 * (lane & 31));
        int R, C; stage_rc(tid * 16 + i * 8192, R, C); const int Rb = Epi::PERM ? ((R & ~31) + perm32(R & 31)) : R;
        voffA[i] = F6A ? v6 : TLA ? (unsigned)(tid * 16 + i * 8192) : (unsigned)(R * K + C) * 2u; voffB[i] = F6B ? v6 : TLB ? (unsigned)(tid * 16 + i * 8192) : (unsigned)(Rb * K + C) * 2u; }
    const size_t kstepA = F6A ? (size_t)12288 : TLA ? (size_t)16384 : (size_t)(BK * 2), kstepB = F6B ? (size_t)12288 : TLB ? (size_t)16384 : (size_t)(BK * 2);
    const size_t hstepA = F6A ? (size_t)nt * 12288 : TLA ? (size_t)nt * 16384 : (size_t)HALF * PITCH, hstepB = F6B ? (size_t)nt * 12288 : TLB ? (size_t)nt * 16384 : (size_t)HALF * PITCH;
    const size_t tstepA = 2 * hstepA, tstepB = 2 * hstepB;
    const unsigned ldsw = (unsigned)wid * 1024u;
    const int aoff = F6A ? (wr * 64 + fr) * 96 + 16 * fq : lds_byte(wr * 64 + fr, fq * 8), boff = F6B ? (wc * 32 + fr) * 96 + 16 * fq : lds_byte(wc * 32 + fr, fq * 8);
    const int s2off = 64 + 8 * (fq ^ ((fr >> 3) << 1)) - 16 * fq;
    constexpr int FSTRA = F6A ? 1536 : 2048, FSTRB = F6B ? 1536 : 2048;
#define PG8_SA(b, h) (((b) * 2 + (h)) * HTB)
#define PG8_SB(b, h) ((4 + (b) * 2 + (h)) * HTB)
#define PG8_STAGE(bufoff, gbase, voff) PG8_STAGE_((bufoff), (gbase), voff, (PG8_IS6(voff)))
#define PG8_IS6(voff) ((const void*)(voff) == (const void*)voffA ? F6A : F6B)
#define PG8_STAGE_(bufoff, gbase, voff, f6_) do { _Pragma("unroll") for (int _i = 0; _i < 2; ++_i) { unsigned vo_ = (voff)[_i]; asm volatile("" : "+v"(vo_));     \
        if (f6_) { if (_i == 0) __builtin_amdgcn_global_load_lds((const PG8_GAS unsigned*)((const PG8_GAS char*)(gbase) + vo_), (PG8_LAS unsigned*)(lds + (bufoff) + ldsw), 16, 0, 0); \
            else if (lane < 32) __builtin_amdgcn_global_load_lds((const PG8_GAS unsigned*)((const PG8_GAS char*)(gbase) + vo_), (PG8_LAS unsigned*)(lds + (bufoff) + 8192 + (ldsw >> 1)), 16, 0, 0); } \
        else __builtin_amdgcn_global_load_lds((const PG8_GAS unsigned*)((const PG8_GAS char*)(gbase) + vo_), (PG8_LAS unsigned*)(lds + (bufoff) + ldsw + _i * 8192), 16, 0, 0); } } while (0)
#define PG8_FRAG(ptr, k, f6_) (((f6_) && (k) == 1) ? frag_lo8(ptr) : *(const PG8_LAS bf16x8*)(ptr))
#define PG8_LDA(dst, b, h) do { _Pragma("unroll") for (int m = 0; m < 4; ++m) _Pragma("unroll") for (int k = 0; k < 2; ++k) dst[m][k] = PG8_FRAG(lds + PG8_SA(b, h) + aoff + m * FSTRA + k * (F6A ? s2off : 1024), k, F6A); } while (0)
#define PG8_LDB(dst, b, h) do { _Pragma("unroll") for (int n = 0; n < 2; ++n) _Pragma("unroll") for (int k = 0; k < 2; ++k) dst[n][k] = PG8_FRAG(lds + PG8_SB(b, h) + boff + n * FSTRB + k * (F6B ? s2off : 1024), k, F6B); } while (0)
#define PG8_MMA(ai, bj, At, Bt) do { __builtin_amdgcn_s_setprio(1); _Pragma("unroll") for (int m = 0; m < 4; ++m) _Pragma("unroll") for (int n = 0; n < 2; ++n) { \
        if constexpr (FP8) { const i32x8 a8_ = __builtin_shufflevector(__builtin_bit_cast(i32x4, At[m][0]), __builtin_bit_cast(i32x4, At[m][1]), 0, 1, 2, 3, 4, 5, 6, 7), b8_ = __builtin_shufflevector(__builtin_bit_cast(i32x4, Bt[n][0]), __builtin_bit_cast(i32x4, Bt[n][1]), 0, 1, 2, 3, 4, 5, 6, 7); \
              \
            acc[ai][bj][m][n] = __builtin_amdgcn_mfma_scale_f32_16x16x128_f8f6f4(b8_, a8_, acc[ai][bj][m][n], F6B ? 2 : 0, F6A ? 2 : 0, 0, 0, 0, 0); } \
        else { _Pragma("unroll") for (int k = 0; k < 2; ++k) acc[ai][bj][m][n] = __builtin_amdgcn_mfma_f32_16x16x32_bf16(Bt[n][k], At[m][k], acc[ai][bj][m][n], 0, 0, 0); } } \
        __builtin_amdgcn_s_setprio(0); } while (0)
#define PG8_WAIT_V(n) asm volatile("s_waitcnt vmcnt(" #n ")" ::: "memory")
#define PG8_WAIT_L(n) asm volatile("s_waitcnt lgkmcnt(" #n ")" ::: "memory")
#define PG8_BAR __builtin_amdgcn_s_barrier()
#define PG8_SCHED __builtin_amdgcn_sched_barrier(0)
    Unit cur, nxt; int ui = 0;
    if (!S.next(0, cur)) return;
    f32x4 acc[2][2][4][2];
#pragma unroll
    for (int a = 0; a < 2; ++a)
#pragma unroll
        for (int b = 0; b < 2; ++b)
#pragma unroll
            for (int m = 0; m < 4; ++m)
#pragma unroll
                for (int n = 0; n < 2; ++n) acc[a][b][m][n] = (f32x4){0.f, 0.f, 0.f, 0.f};
    bf16x8 At[4][2], B0[2][2], B1[2][2];
    bf16x8 At1[4][2];
    constexpr bool EARLY_A1 = F6D;
    const PG8_GAS char* cA = (const PG8_GAS char*)g.A + (size_t)cur.pm * tstepA; const PG8_GAS char* cB = (const PG8_GAS char*)g.Bt + (size_t)cur.pn * tstepB;
    S.a_ready(cur);
    if constexpr (SP2) {
        PG8_STAGE(PG8_SB(0, 0), cB, voffB); PG8_STAGE(PG8_SB(0, 1), cB + hstepB, voffB); PG8_STAGE(PG8_SA(0, 0), cA, voffA); PG8_STAGE(PG8_SA(0, 1), cA + hstepA, voffA);
        if (wr == 1) PG8_BAR;
        PG8_WAIT_V(2); PG8_BAR;
        PG8_STAGE(PG8_SB(1, 0), cB + kstepB, voffB); PG8_STAGE(PG8_SA(1, 0), cA + kstepA, voffA); PG8_STAGE(PG8_SB(1, 1), cB + hstepB + kstepB, voffB);
        PG8_WAIT_V(6); PG8_BAR;
    } else {
        PG8_STAGE(PG8_SB(0, 0), cB, voffB); PG8_STAGE(PG8_SA(0, 0), cA, voffA); PG8_STAGE(PG8_SB(0, 1), cB + hstepB, voffB); PG8_STAGE(PG8_SA(0, 1), cA + hstepA, voffA);
        if (wr == 1) PG8_BAR;
        PG8_WAIT_V(4); PG8_BAR;
        PG8_STAGE(PG8_SB(1, 0), cB + kstepB, voffB); PG8_STAGE(PG8_SA(1, 0), cA + kstepA, voffA); PG8_STAGE(PG8_SB(1, 1), cB + hstepB + kstepB, voffB);
        PG8_WAIT_V(6); PG8_BAR;
    }
    for (;;) {
        const bool has_next = S.next(ui + 1, nxt);
        const PG8_GAS char* nA = has_next ? (const PG8_GAS char*)g.A + (size_t)nxt.pm * tstepA : cA; const PG8_GAS char* nB = has_next ? (const PG8_GAS char*)g.Bt + (size_t)nxt.pn * tstepB : cB;
        for (int t = 0; t < nt; t += 2) {
            const bool last = (t == nt - 2);
            const PG8_GAS char* a1 = cA + (size_t)(t + 1) * kstepA;
            const PG8_GAS char* a2 = last ? nA : cA + (size_t)(t + 2) * kstepA; const PG8_GAS char* b2 = last ? nB : cB + (size_t)(t + 2) * kstepB;
            const PG8_GAS char* a3 = a2 + kstepA; const PG8_GAS char* b3 = b2 + kstepB;
            if (last && has_next) S.a_ready(nxt);
            if constexpr (SP2) {
            PG8_LDB(B0, 0, 0); PG8_LDB(B1, 0, 1); PG8_SCHED; PG8_LDA(At, 0, 0); PG8_STAGE(PG8_SA(1, 1), a1 + hstepA, voffA);
            PG8_WAIT_V(8); PG8_WAIT_L(0); PG8_BAR; if constexpr (EARLY_A1) PG8_LDA(At1, 0, 1); PG8_MMA(0, 0, At, B0); PG8_MMA(0, 1, At, B1); PG8_BAR; PG8_SCHED;
            if constexpr (!EARLY_A1) PG8_LDA(At, 0, 1); PG8_STAGE(PG8_SB(0, 0), b2, voffB); PG8_STAGE(PG8_SB(0, 1), b2 + hstepB, voffB); PG8_STAGE(PG8_SA(0, 0), a2, voffA);
            if constexpr (EARLY_A1) PG8_WAIT_V(6); else PG8_WAIT_V(8);
            PG8_WAIT_L(0); PG8_BAR; if constexpr (EARLY_A1) { PG8_MMA(1, 0, At1, B0); PG8_MMA(1, 1, At1, B1); } else { PG8_MMA(1, 0, At, B0); PG8_MMA(1, 1, At, B1); } PG8_BAR; PG8_SCHED;
            PG8_LDB(B0, 1, 0); PG8_LDB(B1, 1, 1); PG8_SCHED; PG8_LDA(At, 1, 0); PG8_STAGE(PG8_SA(0, 1), a2 + hstepA, voffA);
            PG8_WAIT_V(8); PG8_WAIT_L(0); PG8_BAR; if constexpr (EARLY_A1) PG8_LDA(At1, 1, 1); PG8_MMA(0, 0, At, B0); PG8_MMA(0, 1, At, B1); PG8_BAR; PG8_SCHED;
            if constexpr (!EARLY_A1) PG8_LDA(At, 1, 1); PG8_STAGE(PG8_SB(1, 0), b3, voffB); PG8_STAGE(PG8_SB(1, 1), b3 + hstepB, voffB); PG8_STAGE(PG8_SA(1, 0), a3, voffA);
            if constexpr (EARLY_A1) PG8_WAIT_V(6); else PG8_WAIT_V(8);
            PG8_WAIT_L(0); PG8_BAR; if constexpr (EARLY_A1) { PG8_MMA(1, 0, At1, B0); PG8_MMA(1, 1, At1, B1); } else { PG8_MMA(1, 0, At, B0); PG8_MMA(1, 1, At, B1); } PG8_BAR; PG8_SCHED;
            } else {
            PG8_LDB(B0, 0, 0); PG8_SCHED; PG8_LDA(At, 0, 0); PG8_STAGE(PG8_SA(1, 1), a1 + hstepA, voffA);
            PG8_WAIT_L(8); PG8_BAR; PG8_WAIT_L(0); PG8_MMA(0, 0, At, B0); PG8_BAR; PG8_SCHED;
            PG8_LDB(B1, 0, 1); PG8_STAGE(PG8_SB(0, 0), b2, voffB);
            PG8_BAR; PG8_WAIT_L(0); PG8_MMA(0, 1, At, B1); PG8_BAR;
            PG8_LDA(At, 0, 1); PG8_STAGE(PG8_SA(0, 0), a2, voffA);
            PG8_BAR; PG8_WAIT_L(0); PG8_MMA(1, 0, At, B0); PG8_BAR; PG8_SCHED;
            PG8_STAGE(PG8_SB(0, 1), b2 + hstepB, voffB);
            PG8_WAIT_V(6); PG8_BAR; PG8_MMA(1, 1, At, B1); PG8_BAR;
            PG8_LDB(B0, 1, 0); PG8_SCHED; PG8_LDA(At, 1, 0); PG8_STAGE(PG8_SA(0, 1), a2 + hstepA, voffA);
            PG8_WAIT_L(8); PG8_BAR; PG8_WAIT_L(0); PG8_MMA(0, 0, At, B0); PG8_BAR; PG8_SCHED;
            PG8_LDB(B1, 1, 1); PG8_STAGE(PG8_SB(1, 0), b3, voffB);
            PG8_BAR; PG8_WAIT_L(0); PG8_MMA(0, 1, At, B1); PG8_BAR;
            PG8_LDA(At, 1, 1); PG8_STAGE(PG8_SA(1, 0), a3, voffA);
            PG8_BAR; PG8_WAIT_L(0); PG8_MMA(1, 0, At, B0); PG8_BAR; PG8_SCHED;
            PG8_STAGE(PG8_SB(1, 1), b3 + hstepB, voffB);
            PG8_WAIT_V(6); PG8_BAR; PG8_MMA(1, 1, At, B1); PG8_BAR;
            }
        }
        if constexpr (ALIGN_EPI) { if (wr == 0) PG8_BAR; }
        if constexpr (!Epi::AFTER_DRAIN) { E(acc, cur, wr, wc, fr, fq); S.done(cur); }
        if (!has_next) break;
#pragma unroll
        for (int a = 0; a < 2; ++a)
#pragma unroll
            for (int b = 0; b < 2; ++b)
#pragma unroll
                for (int m = 0; m < 4; ++m)
#pragma unroll
                    for (int n = 0; n < 2; ++n) acc[a][b][m][n] = (f32x4){0.f, 0.f, 0.f, 0.f};
        cur = nxt; cA = nA; cB = nB; ++ui;
        if constexpr (ALIGN_EPI) { if (wr == 1) PG8_BAR; }
    }
    PG8_WAIT_V(0);
    if constexpr (!ALIGN_EPI) { if (wr == 0) PG8_BAR; }
    PG8_BAR;
    if constexpr (Epi::AFTER_DRAIN) { E.fused(acc, cur, wr, wc, fr, fq, lds, wid, lane); S.done(cur); }
#undef PG8_SA
#undef PG8_SB
#undef PG8_STAGE
#undef PG8_STAGE_
#undef PG8_IS6
#undef PG8_FRAG
#undef PG8_LDA
#undef PG8_LDB
#undef PG8_MMA
#undef PG8_WAIT_V
#undef PG8_WAIT_L
#undef PG8_BAR
#undef PG8_SCHED
}
}

constexpr int T = 16384, D = 4096;
constexpr int EV_IN = 10240;
constexpr int OD_IN = 18560, OD_INP = 18688;
constexpr int XBC = 10240, SSM_INNER = 8192, NHEAD = 128, NE = 16384, QW = 2048;
constexpr float EPS = 1e-6f;
constexpr int NPHASE = 21, NCU = 256;

constexpr size_t MiB = 1u << 20;
constexpr size_t WS_CTL = 0, CTL_ZERO_BYTES = 1 * MiB;
constexpr size_t WS_KEYS = 2 * MiB;
constexpr size_t WS_WIN0 = 4 * MiB, WS_WOUT0 = 84 * MiB, WS_WQ0 = 116 * MiB, WS_U0 = 132 * MiB, WS_V0 = 196 * MiB;
constexpr size_t WS_WIN1 = 4 * MiB, WS_WOUT1 = 150 * MiB, WS_WQ1 = 214 * MiB, WS_U1 = 230 * MiB, WS_V1 = 294 * MiB;
constexpr size_t WS_HN = 358 * MiB;
constexpr size_t WS_HN8 = 486 * MiB;
constexpr size_t WS_PROJ = 550 * MiB;
constexpr size_t WS_YCAT = 1134 * MiB;
constexpr size_t WS_Q = 1390 * MiB;
constexpr size_t WS_G = 1454 * MiB;
constexpr size_t WS_HB = WS_G + 256 * MiB;
constexpr size_t WS_STATE = WS_G, WS_AEND = WS_G + 512 * MiB;
constexpr size_t WS_END = 2046 * MiB;
constexpr float PEER_U6 = 96.0f, PEER_A6 = 1.25f;
constexpr float OUT1_W6 = 136.0f;
constexpr float PEER_V6 = 4.25f;
constexpr float PEER_US = 64.0f, PEER_GS = 64.0f, PEER_VS = 4.0f;
constexpr int CW_BAR = 4096;

constexpr int LDS_BYTES = 147456, MISC_OFF = LDS_BYTES - 256;

#define GAS __attribute__((address_space(1)))
#define LAS __attribute__((address_space(3)))
typedef unsigned short bf16;
typedef unsigned v4u __attribute__((ext_vector_type(4)));
typedef unsigned v2u __attribute__((ext_vector_type(2)));
typedef float f32x4 __attribute__((ext_vector_type(4)));
typedef float f32x16 __attribute__((ext_vector_type(16)));
typedef short bf16x8 __attribute__((ext_vector_type(8)));
#define LDS_WAIT() asm volatile("s_waitcnt lgkmcnt(0)" ::: "memory")
#define VM_WAIT() asm volatile("s_waitcnt vmcnt(0)" ::: "memory")
__device__ __forceinline__ unsigned pk2(float lo, float hi) { return pg8::cvt_pk_bf16(lo, hi); }
__device__ __forceinline__ float bflo(unsigned w) { return __uint_as_float(w << 16); }
__device__ __forceinline__ float bfhi(unsigned w) { return __uint_as_float(w & 0xffff0000u); }
__device__ __forceinline__ float bf2f(bf16 b) { return __uint_as_float(((unsigned)b) << 16); }
__device__ __forceinline__ void unpack8(const v4u v, float (&f)[8]) { f[0] = bflo(v.x); f[1] = bfhi(v.x); f[2] = bflo(v.y); f[3] = bfhi(v.y); f[4] = bflo(v.z); f[5] = bfhi(v.z); f[6] = bflo(v.w); f[7] = bfhi(v.w); }
__device__ __forceinline__ v4u pack8(const float (&f)[8]) { v4u o; o.x = pk2(f[0], f[1]); o.y = pk2(f[2], f[3]); o.z = pk2(f[4], f[5]); o.w = pk2(f[6], f[7]); return o; }
__device__ __forceinline__ float wave_sum(float v) {
#pragma unroll
    for (int o = 1; o < 64; o <<= 1) v += __shfl_xor(v, o);
    return v;
}
__device__ __forceinline__ float silu_f(float x) { return x * __builtin_amdgcn_rcpf(1.0f + __builtin_amdgcn_exp2f(-1.4426950409f * x)); }
__device__ __forceinline__ float exp_f(float x) { return __builtin_amdgcn_exp2f(1.4426950409f * x); }

#define XB_TMO      128
#define XB_XCNT(j)  (256  + 64 * (j))
#define XB_XSUB(j)  (1280 + 64 * (j))
#define XB_XGEN(j)  (2304 + 64 * (j))
#define XB_TOP      3328
#define XB_TOPGEN   3392
#define XCD_BAR_WORDS 3456
#define XB_SPIN_CAP (1u << 20)
__device__ __forceinline__ unsigned xb_ld(unsigned* p)              { return __hip_atomic_load(p, __ATOMIC_RELAXED, __HIP_MEMORY_SCOPE_AGENT); }
__device__ __forceinline__ unsigned xb_add(unsigned* p, unsigned v) { return __hip_atomic_fetch_add(p, v, __ATOMIC_RELAXED, __HIP_MEMORY_SCOPE_AGENT); }
__device__ __forceinline__ unsigned xb_xcc_id() { return (unsigned)__builtin_amdgcn_s_getreg((3 << 11) | 20) & 0xFu; }
#define XB_SPIN(cond, bar) do { unsigned _sp = 0; while (cond) { __builtin_amdgcn_s_sleep(1); \
    if ((++_sp & 255u) == 0u) { if (xb_ld(&(bar)[XB_TMO])) break; if (_sp > XB_SPIN_CAP) { atomicAdd(&(bar)[XB_TMO], 1u); break; } } } } while (0)
struct XcdBarrier { unsigned* bar; unsigned x; volatile LAS unsigned* st; };
__device__ __forceinline__ XcdBarrier xcd_barrier_post(unsigned* bar, volatile LAS unsigned* st, int tid) {
    XcdBarrier b; b.bar = bar; b.x = xb_xcc_id(); b.st = st;
    if (tid == 0) (void)xb_add(&bar[XB_XCNT(b.x)], 1u);
    return b;
}
__device__ __forceinline__ void xcd_barrier_complete(unsigned* bar, unsigned x, unsigned& nloc, unsigned& nx) {
    const unsigned G = NCU;
    unsigned sum, cnt, mine, sp = 0u;
    for (;;) {
        sum = 0u; cnt = 0u; mine = 0u;
#pragma unroll
        for (unsigned j = 0; j < 16; ++j) { const unsigned c = xb_ld(&bar[XB_XCNT(j)]); sum += c; cnt += (c > 0u) ? 1u : 0u; mine = (j == x) ? c : mine; }
        if (sum == G) break;
        __builtin_amdgcn_s_sleep(1);
        if ((++sp & 255u) == 0u) { if (xb_ld(&bar[XB_TMO])) break; if (sp > XB_SPIN_CAP) { atomicAdd(&bar[XB_TMO], 1u); break; } }
    }
    nloc = mine > 0u ? mine : 1u; nx = cnt > 0u ? cnt : 1u;
}
__device__ __forceinline__ void xcd_barrier(const XcdBarrier& b, int tid) {
    asm volatile("s_waitcnt vmcnt(0)" ::: "memory");
    __syncthreads();
    if (tid == 0) {
        unsigned* bar = b.bar;
        __builtin_amdgcn_s_waitcnt(0);
        unsigned nloc = b.st[0], nx = b.st[1];
        if (nloc == 0u) { xcd_barrier_complete(bar, b.x, nloc, nx); b.st[0] = nloc; b.st[1] = nx; }
        const unsigned old = xb_add(&bar[XB_XSUB(b.x)], 1u);
        const unsigned gen = old / nloc;
        if (old + 1u == (gen + 1u) * nloc) {
            __builtin_amdgcn_fence(__ATOMIC_RELEASE, "agent");
            asm volatile("s_waitcnt vmcnt(0)" ::: "memory");
            const unsigned og = xb_add(&bar[XB_TOP], 1u);
            const unsigned tg = og / nx;
            if (og + 1u == (tg + 1u) * nx) xb_add(&bar[XB_TOPGEN], 1u);
            else XB_SPIN(xb_ld(&bar[XB_TOPGEN]) == tg, bar);
            __builtin_amdgcn_fence(__ATOMIC_ACQUIRE, "agent");
            xb_add(&bar[XB_XGEN(b.x)], 1u);
            asm volatile("s_waitcnt vmcnt(0)" ::: "memory");
        } else {
            XB_SPIN(xb_ld(&bar[XB_XGEN(b.x)]) == gen, bar);
            __builtin_amdgcn_fence(__ATOMIC_ACQUIRE, "agent");
            asm volatile("s_waitcnt vmcnt(0)" ::: "memory");
        }
    }
    __syncthreads();
}

struct Frame { LAS unsigned char* lds; int tid, lane, wave, vcu, G; };

__device__ __forceinline__ int fp6_slot_a(int row) { return row & 127; }
__device__ __forceinline__ int fp6_slot_b(int row) { return (row & 96) + 16 * ((row >> 2) & 1) + 4 * ((row >> 3) & 3) + (row & 3); }
__device__ __forceinline__ size_t tiled_off(int row, int kt, int nt, int cb, bool perm) {
    const int r = row & 127, slot = perm ? fp6_slot_b(r) : r;
    return ((size_t)(row >> 7) * nt + kt) * 16384 + pg8::lds_byte(slot, cb >> 1);
}
__device__ __forceinline__ void transpose_matrix(const Frame& F, const float* W, int K, int N, bf16* WT, int tl  , const float* kscale = nullptr  ) {
    LAS float* scr = (LAS float*)(F.lds + F.wave * 16896);
    const int gw = F.vcu * 8 + F.wave, NGW = F.G * 8, nblk = N / 64, nitems = (K / 64) * nblk;
    const int r4 = F.lane >> 4, c4 = (F.lane & 15) * 4, c = F.lane & 7;
    for (int it = gw; it < nitems; it += NGW) {
        const int kb = it / nblk, nb = it % nblk, k0 = 64 * kb, n0 = 64 * nb;
        f32x4 v[16];
#pragma unroll
        for (int i = 0; i < 16; ++i) v[i] = *(const f32x4*)(W + (size_t)(k0 + 4 * i + r4) * N + n0 + c4);
#pragma unroll
        for (int i = 0; i < 16; ++i) { LAS float* d = scr + (4 * i + r4) * 65 + c4; const float ks_ = kscale ? kscale[k0 + 4 * i + r4] : 1.0f; d[0] = v[i][0] * ks_; d[1] = v[i][1] * ks_; d[2] = v[i][2] * ks_; d[3] = v[i][3] * ks_; }
        LDS_WAIT();
#pragma unroll
        for (int j = 0; j < 8; ++j) { const int n = (F.lane >> 3) + 8 * j; const LAS float* sp = scr + (8 * c) * 65 + n;
            v4u o; o.x = pk2(sp[0 * 65], sp[1 * 65]); o.y = pk2(sp[2 * 65], sp[3 * 65]); o.z = pk2(sp[4 * 65], sp[5 * 65]); o.w = pk2(sp[6 * 65], sp[7 * 65]);
            *(v4u*)((unsigned char*)WT + tiled_off(n0 + n, kb, K / 64, 16 * c, tl == 2)) = o; }
        LDS_WAIT();
    }
}
__device__ __forceinline__ void convert_matrix(const Frame& F, const float* W, bf16* O, size_t n8) {
    const size_t gt = (size_t)F.vcu * 512 + F.tid, NT = (size_t)F.G * 512;
    for (size_t i = gt; i < n8; i += NT) { const f32x4 a = ((const f32x4*)W)[2 * i], b = ((const f32x4*)W)[2 * i + 1];
        v4u o; o.x = pk2(a[0], a[1]); o.y = pk2(a[2], a[3]); o.z = pk2(b[0], b[1]); o.w = pk2(b[2], b[3]); ((v4u*)O)[i] = o; }
}
__device__ __forceinline__ void convert_matrix_fp8(const Frame& F, const float* W, unsigned char* O, size_t n16, float sc) {
    const size_t nblk = n16 / 64;
    const size_t gw = (size_t)F.vcu * 8 + F.wave, NGW = (size_t)F.G * 8;
    for (size_t blk = gw; blk < nblk; blk += NGW) {
        const f32x4* src = (const f32x4*)(W + blk * 1024) + F.lane; int* dst = (int*)(O + blk * 1024) + F.lane;
        f32x4 a[4];
#pragma unroll
        for (int q = 0; q < 4; ++q) a[q] = src[64 * q];
#pragma unroll
        for (int q = 0; q < 4; ++q) { const f32x4 x = a[q] * sc; int w = 0; w = __builtin_amdgcn_cvt_pk_fp8_f32(x[0], x[1], w, false); w = __builtin_amdgcn_cvt_pk_fp8_f32(x[2], x[3], w, true); dst[64 * q] = w; }
    }
}
typedef float f32x16v __attribute__((ext_vector_type(16)));
typedef int i32x6v __attribute__((ext_vector_type(6)));
__device__ __forceinline__ void store_fp6_block(unsigned char* base, size_t row, int slot, int nt  , int blk  , const f32x16v lo, const f32x16v hi) {
    const i32x6v r = __builtin_amdgcn_cvt_scalef32_2xpk16_fp6_f32(lo, hi, 1.0f);
    const int t = blk >> 2, q = blk & 3; unsigned char* p0 = base + (((row >> 7) * (size_t)nt + t) * 128 + slot) * 96;
    v4u a; a.x = (unsigned)r[0]; a.y = (unsigned)r[1]; a.z = (unsigned)r[2]; a.w = (unsigned)r[3]; *(v4u*)(p0 + 16 * q) = a;
    v2u b; b.x = (unsigned)r[4]; b.y = (unsigned)r[5]; *(v2u*)(p0 + 64 + 8 * (q ^ (((slot >> 3) & 1) << 1))) = b;
}
__device__ __forceinline__ void convert_matrix_fp6(const Frame& F, const float* W, unsigned char* O, int K, size_t nblocks, float sc) {
    LAS float* hr = (LAS float*)(F.lds + F.wave * 16896);
    const size_t nstep = nblocks / 64, gw = (size_t)F.vcu * 8 + F.wave, NGW = (size_t)F.G * 8; const int bpr = K / 32;
    for (size_t st = gw; st < nstep; st += NGW) {
        const f32x4* src = (const f32x4*)(W + st * 2048) + F.lane; f32x4 v[8];
#pragma unroll
        for (int q = 0; q < 8; ++q) v[q] = src[64 * q];
#pragma unroll
        for (int q = 0; q < 8; ++q) { const int e = 4 * F.lane + 256 * q; *(LAS f32x4*)(hr + e + 4 * (e >> 5)) = v[q] * sc; }
        LDS_WAIT();
        f32x16v lo, hi; const LAS f32x4* bp = (const LAS f32x4*)(hr + 36 * F.lane);
#pragma unroll
        for (int i = 0; i < 4; ++i) { const f32x4 x = bp[i], z = bp[4 + i]; lo[4 * i] = x[0]; lo[4 * i + 1] = x[1]; lo[4 * i + 2] = x[2]; lo[4 * i + 3] = x[3]; hi[4 * i] = z[0]; hi[4 * i + 1] = z[1]; hi[4 * i + 2] = z[2]; hi[4 * i + 3] = z[3]; }
        const size_t b = st * 64 + F.lane, row = b / bpr; store_fp6_block(O, row, fp6_slot_b((int)(row & 127)), K / 128, (int)(b % bpr), lo, hi);
        LDS_WAIT();
    }
}
__device__ __forceinline__ void transpose_matrix_fp8(const Frame& F, const float* W, int K, int N, unsigned char* WT, float sc, int tl) {
    LAS float* scr = (LAS float*)(F.lds + F.wave * 16896);
    const int gw = F.vcu * 8 + F.wave, NGW = F.G * 8, nblk = N / 32, nitems = (K / 128) * nblk;
    const int r8 = F.lane >> 3, c4 = (F.lane & 7) * 4, c = F.lane & 7;
    for (int it = gw; it < nitems; it += NGW) {
        const int kb = it / nblk, nb = it % nblk, k0 = 128 * kb, n0 = 32 * nb;
        f32x4 v[16];
#pragma unroll
        for (int i = 0; i < 16; ++i) v[i] = *(const f32x4*)(W + (size_t)(k0 + 8 * i + r8) * N + n0 + c4);
#pragma unroll
        for (int i = 0; i < 16; ++i) { LAS float* d = scr + (8 * i + r8) * 33 + c4; d[0] = v[i][0] * sc; d[1] = v[i][1] * sc; d[2] = v[i][2] * sc; d[3] = v[i][3] * sc; }
        LDS_WAIT();
#pragma unroll
        for (int j = 0; j < 4; ++j) { const int n = (F.lane >> 3) + 8 * j; const LAS float* sp = scr + (16 * c) * 33 + n; v4u o;
#pragma unroll
            for (int q = 0; q < 4; ++q) { int w = 0; w = __builtin_amdgcn_cvt_pk_fp8_f32(sp[(4 * q) * 33], sp[(4 * q + 1) * 33], w, false); w = __builtin_amdgcn_cvt_pk_fp8_f32(sp[(4 * q + 2) * 33], sp[(4 * q + 3) * 33], w, true); o[q] = (unsigned)w; }
            *(v4u*)(WT + tiled_off(n0 + n, kb, K / 128, 16 * c, tl == 2)) = o; }
        LDS_WAIT();
    }
}
__device__ __forceinline__ void transpose_matrix_fp6(const Frame& F, const float* W, int K, int N, unsigned char* WT, float sc, bool mixed = false  ) {
    LAS float* scr = (LAS float*)(F.lds + F.wave * 16896);
    const int gw = F.vcu * 8 + F.wave, NGW = F.G * 8, nblk = N / 32, nitems = (K / 128) * nblk;
    const int r8 = F.lane >> 3, c4 = (F.lane & 7) * 4;
    for (int it = gw; it < nitems; it += NGW) {
        const int kb = it / nblk, nb = it % nblk, k0 = 128 * kb, n0 = 32 * nb;
        f32x4 v[16];
#pragma unroll
        for (int i = 0; i < 16; ++i) v[i] = *(const f32x4*)(W + (size_t)(k0 + 8 * i + r8) * N + n0 + c4);
#pragma unroll
        for (int i = 0; i < 16; ++i) { LAS float* d = scr + (8 * i + r8) * 33 + c4; d[0] = v[i][0] * sc; d[1] = v[i][1] * sc; d[2] = v[i][2] * sc; d[3] = v[i][3] * sc; }
        LDS_WAIT();
#pragma unroll
        for (int j = 0; j < 2; ++j) { const int p = F.lane + 64 * j, n = p & 31, blk = p >> 5; const LAS float* sp = scr + (mixed ? 16 * blk : 32 * blk) * 33 + n; f32x16v lo, hi;
#pragma unroll
            for (int i = 0; i < 16; ++i) {
                if (mixed) { const int r0 = 16 * blk + 2 * i; lo[i] = sp[r0 * 33]; hi[i] = sp[(r0 + 1) * 33]; }
                else { lo[i] = sp[i * 33]; hi[i] = sp[(16 + i) * 33]; } }
            store_fp6_block(WT, (size_t)(n0 + n), mixed ? fp6_slot_a(n0 + n) : fp6_slot_b((n0 + n) & 127), K / 128, 4 * kb + blk, lo, hi); }
        LDS_WAIT();
    }
}
__device__ __forceinline__ void zero_bytes(const Frame& F, void* p, size_t n16) {
    const size_t gt = (size_t)F.vcu * 512 + F.tid, NT = (size_t)F.G * 512; const v4u z = {0u, 0u, 0u, 0u};
    for (size_t i = gt; i < n16; i += NT) ((v4u*)p)[i] = z;
}
template <bool SB> __device__ __forceinline__ void rms_load_row(f32x4 (&v)[16], const void* src, int row, int lane) {
    if constexpr (SB) { const v2u* xr = (const v2u*)((const bf16*)src + (size_t)row * D) + lane;
#pragma unroll
        for (int j = 0; j < 16; ++j) { const v2u t = xr[64 * j]; v[j] = (f32x4){bflo(t.x), bfhi(t.x), bflo(t.y), bfhi(t.y)}; } }
    else { const f32x4* xr = (const f32x4*)((const float*)src + (size_t)row * D) + lane;
#pragma unroll
        for (int j = 0; j < 16; ++j) v[j] = xr[64 * j]; }
}
template <bool SB> __device__ __forceinline__ void rms_rows_bf16(const Frame& F, const void* src, const float* g, bf16* dst, unsigned char* dst8 = nullptr, unsigned char* dst6 = nullptr, float sc6 = 1.0f, float* rstd_out = nullptr) {
    const int gw = F.vcu * 8 + F.wave, NGW = F.G * 8;
    f32x4 v[16], nx[16];
    if (gw < T) rms_load_row<SB>(v, src, gw, F.lane);
    for (int m = gw; m < T; m += NGW) {
        const int mn = m + NGW;
        if (mn < T) rms_load_row<SB>(nx, src, mn, F.lane);
        float s = 0.f;
#pragma unroll
        for (int j = 0; j < 16; ++j) s += (v[j].x * v[j].x + v[j].y * v[j].y) + (v[j].z * v[j].z + v[j].w * v[j].w);
        const float rstd = 1.0f / sqrtf(wave_sum(s) * (1.0f / D) + EPS);
        if (rstd_out && F.lane == 0) rstd_out[m] = rstd;
        v2u* o8 = (v2u*)(dst + (size_t)m * D) + F.lane;
#pragma unroll
        for (int j = 0; j < 16; ++j) { const f32x4 gv = ((const f32x4*)g)[F.lane + 64 * j]; const f32x4 y = v[j] * rstd * gv; if (dst) { v2u o; o.x = pk2(y.x, y.y); o.y = pk2(y.z, y.w); o8[64 * j] = o; }
            if (dst8) { int w = 0; w = __builtin_amdgcn_cvt_pk_fp8_f32(y.x, y.y, w, false); w = __builtin_amdgcn_cvt_pk_fp8_f32(y.z, y.w, w, true); ((int*)(dst8 + (size_t)m * D))[F.lane + 64 * j] = w; } }
        if (dst6) {
            LAS float* hr = (LAS float*)(F.lds + F.wave * 16896);
#pragma unroll
            for (int hf = 0; hf < 2; ++hf) {
#pragma unroll
                for (int j8 = 0; j8 < 8; ++j8) { const int j = 8 * hf + j8; const f32x4 gv = ((const f32x4*)g)[F.lane + 64 * j]; const f32x4 y = v[j] * (rstd * sc6) * gv; const int e = 4 * F.lane + 256 * j8;
                    *(LAS f32x4*)(hr + e + 4 * (e >> 5)) = y; }
                LDS_WAIT();
                f32x16v lo, hi; const LAS f32x4* bp = (const LAS f32x4*)(hr + 36 * F.lane);
#pragma unroll
                for (int i = 0; i < 4; ++i) { const f32x4 x = bp[i], z = bp[4 + i]; lo[4 * i] = x[0]; lo[4 * i + 1] = x[1]; lo[4 * i + 2] = x[2]; lo[4 * i + 3] = x[3]; hi[4 * i] = z[0]; hi[4 * i + 1] = z[1]; hi[4 * i + 2] = z[2]; hi[4 * i + 3] = z[3]; }
                store_fp6_block(dst6, (size_t)m, fp6_slot_a(m), D / 128, 64 * hf + F.lane, lo, hi);
                LDS_WAIT(); } }
#pragma unroll
        for (int j = 0; j < 16; ++j) v[j] = nx[j];
    }
}
__device__ __forceinline__ void rms_rows_final(const Frame& F, const bf16* hb, const float* g, float* out) {
    const int gw = F.vcu * 8 + F.wave, NGW = F.G * 8;
    f32x4 v[16], nx[16];
    if (gw < T) rms_load_row<true>(v, hb, gw, F.lane);
    for (int m = gw; m < T; m += NGW) {
        const int mn = m + NGW;
        if (mn < T) rms_load_row<true>(nx, hb, mn, F.lane);
        float s = 0.f;
#pragma unroll
        for (int j = 0; j < 16; ++j) s += (v[j].x * v[j].x + v[j].y * v[j].y) + (v[j].z * v[j].z + v[j].w * v[j].w);
        const float rstd = 1.0f / sqrtf(wave_sum(s) * (1.0f / D) + EPS);
        f32x4* xw = (f32x4*)(out + (size_t)m * D) + F.lane;
#pragma unroll
        for (int j = 0; j < 16; ++j) { const f32x4 gv = ((const f32x4*)g)[F.lane + 64 * j]; xw[64 * j] = v[j] * rstd * gv; }
#pragma unroll
        for (int j = 0; j < 16; ++j) v[j] = nx[j];
    }
}

constexpr int VT_PITCH = 136;
__device__ __forceinline__ void phase_conv_sgu(const Frame& F, const bf16* proj, const float* conv_w, const float* sgu_norm, const float* sgu_w, const float* sgu_b, bf16* ycat) {
    for (int tb = F.vcu; tb < T / 64; tb += F.G) {
        const int c0 = (F.tid & 255) * 8, t0 = tb * 64 + (F.tid >> 8) * 32;
        float w0[8], w1[8], w2[8], p1[8], p2[8];
#pragma unroll
        for (int j = 0; j < 8; ++j) { w0[j] = conv_w[c0 + j]; w1[j] = conv_w[2048 + c0 + j]; w2[j] = conv_w[4096 + c0 + j]; p1[j] = 0.f; p2[j] = 0.f; }
        if (t0 >= 2) {
            float a[8], b[8];
            unpack8(*(const v4u*)(proj + (size_t)(t0 - 2) * EV_IN + 2048 + c0), a); unpack8(*(const v4u*)(proj + (size_t)(t0 - 2) * EV_IN + 4096 + c0), b);
#pragma unroll
            for (int j = 0; j < 8; ++j) p2[j] = a[j] * b[j];
            unpack8(*(const v4u*)(proj + (size_t)(t0 - 1) * EV_IN + 2048 + c0), a); unpack8(*(const v4u*)(proj + (size_t)(t0 - 1) * EV_IN + 4096 + c0), b);
#pragma unroll
            for (int j = 0; j < 8; ++j) p1[j] = a[j] * b[j];
        }
#pragma unroll 4
        for (int i = 0; i < 32; ++i) {
            const bf16* row = proj + (size_t)(t0 + i) * EV_IN + c0;
            float gb[8], gc[8], xt[8], y[8];
            unpack8(*(const v4u*)(row), gb); unpack8(*(const v4u*)(row + 2048), gc); unpack8(*(const v4u*)(row + 4096), xt);
#pragma unroll
            for (int j = 0; j < 8; ++j) { const float pr = gc[j] * xt[j]; y[j] = gb[j] * (w0[j] * p2[j] + w1[j] * p1[j] + w2[j] * pr); p2[j] = p1[j]; p1[j] = pr; }
            *(v4u*)(ycat + (size_t)(t0 + i) * D + c0) = pack8(y);
        }
    }
    LAS float* stats = (LAS float*)F.lds;
    LAS bf16* vT = (LAS bf16*)(F.lds + 1024);
    const int fr = F.lane & 15, fq = F.lane >> 4;
    for (int u = F.vcu; u < 256; u += F.G) {
        const int n = u >> 1, gh = u & 1, t0 = n * 128;
        __syncthreads();
        for (int tt = 0; tt < 16; ++tt) {
            const int tl = F.wave * 16 + tt; const bf16* row = proj + (size_t)(t0 + tl) * EV_IN + 8192;
            float s = 0.f, s2 = 0.f;
#pragma unroll
            for (int j = 0; j < 4; ++j) { float x[8]; unpack8(*(const v4u*)(row + 8 * (F.lane + 64 * j)), x);
#pragma unroll
                for (int k = 0; k < 8; ++k) { s += x[k]; s2 += x[k] * x[k]; } }
            s = wave_sum(s); s2 = wave_sum(s2);
            const float mu = s * (1.0f / 2048.0f), var = fmaxf(s2 * (1.0f / 2048.0f) - mu * mu, 0.f);
            if (F.lane == 0) { stats[2 * tl] = mu; stats[2 * tl + 1] = 1.0f / sqrtf(var + EPS); }
        }
        __syncthreads();
        for (int g8 = 0; g8 < 8; ++g8) {
            const int g = gh * 8 + g8;
            { const int cgrp = F.tid & 15, pl = F.tid >> 4; float ng[8];
#pragma unroll
              for (int j = 0; j < 8; ++j) ng[j] = sgu_norm[g * 128 + cgrp * 8 + j];
#pragma unroll
              for (int pp = 0; pp < 4; ++pp) { const int p = pl + 32 * pp; float x[8]; unpack8(*(const v4u*)(proj + (size_t)(t0 + p) * EV_IN + 8192 + g * 128 + cgrp * 8), x);
                  const float mu = stats[2 * p], rs = stats[2 * p + 1];
#pragma unroll
                  for (int j = 0; j < 8; j += 2) { const unsigned w = pk2((x[j] - mu) * rs * ng[j], (x[j + 1] - mu) * rs * ng[j + 1]);
                      vT[(cgrp * 8 + j) * VT_PITCH + p] = (bf16)(w & 0xffffu); vT[(cgrp * 8 + j + 1) * VT_PITCH + p] = (bf16)(w >> 16); } } }
            __syncthreads();
            f32x4 acc[8];
#pragma unroll
            for (int nt = 0; nt < 8; ++nt) acc[nt] = (f32x4){0.f, 0.f, 0.f, 0.f};
            const int q = F.wave * 16 + fr;
            for (int ks = 0; ks < 4; ++ks) {
                if (32 * ks > F.wave * 16 + 15) break;
                const int p0 = 32 * ks + 8 * fq; const float* wrow = sgu_w + ((size_t)(g * 128 + q)) * 128 + p0;
                const f32x4 wa = *(const f32x4*)wrow, wb = *(const f32x4*)(wrow + 4);
                float wv[8] = {wa[0], wa[1], wa[2], wa[3], wb[0], wb[1], wb[2], wb[3]};
#pragma unroll
                for (int j = 0; j < 8; ++j) wv[j] = (p0 + j <= q) ? wv[j] : 0.f;
                const v4u ap = pack8(wv); const bf16x8 af = __builtin_bit_cast(bf16x8, ap);
#pragma unroll
                for (int nt = 0; nt < 8; ++nt) { const bf16x8 bfr = *(const LAS bf16x8*)(vT + (16 * nt + fr) * VT_PITCH + p0);
                    acc[nt] = __builtin_amdgcn_mfma_f32_16x16x32_bf16(bfr, af, acc[nt], 0, 0, 0); }
            }
            const float bq = sgu_b[g * 128 + q]; const int t = t0 + q;
#pragma unroll
            for (int nt = 0; nt < 8; ++nt) { const int c = g * 128 + 16 * nt + 4 * fq; const v2u uu = *(const v2u*)(proj + (size_t)t * EV_IN + 6144 + c);
                v2u o; o.x = pk2(bflo(uu.x) * (acc[nt][0] + bq), bfhi(uu.x) * (acc[nt][1] + bq)); o.y = pk2(bflo(uu.y) * (acc[nt][2] + bq), bfhi(uu.y) * (acc[nt][3] + bq));
                *(v2u*)(ycat + (size_t)t * D + 2048 + c) = o; }
            __syncthreads();
        }
    }
}

__device__ __forceinline__ unsigned ord_f(float f) { const unsigned u = __float_as_uint(f); return u ^ ((unsigned)((int)u >> 31) | 0x80000000u); }
__device__ __forceinline__ float unord_f(unsigned k) { return __uint_as_float(k ^ ((k & 0x80000000u) ? 0x80000000u : 0xffffffffu)); }
#define CE_(L, a, b) { const unsigned h_ = L[a] > L[b] ? L[a] : L[b]; L[b] = L[a] > L[b] ? L[b] : L[a]; L[a] = h_; }
#define SORT16_DESC(L) do { CE_(L, 0, 1) CE_(L, 2, 3) CE_(L, 0, 2) CE_(L, 1, 3) CE_(L, 1, 2) CE_(L, 4, 5) CE_(L, 6, 7) CE_(L, 4, 6) CE_(L, 5, 7) CE_(L, 5, 6) CE_(L, 0, 4) CE_(L, 2, 6) CE_(L, 2, 4) CE_(L, 1, 5) CE_(L, 3, 7) CE_(L, 3, 5) CE_(L, 1, 2) CE_(L, 3, 4) CE_(L, 5, 6) CE_(L, 8, 9) CE_(L, 10, 11) CE_(L, 8, 10) CE_(L, 9, 11) CE_(L, 9, 10) CE_(L, 12, 13) CE_(L, 14, 15) CE_(L, 12, 14) CE_(L, 13, 15) CE_(L, 13, 14) CE_(L, 8, 12) CE_(L, 10, 14) CE_(L, 10, 12) CE_(L, 9, 13) CE_(L, 11, 15) CE_(L, 11, 13) CE_(L, 9, 10) CE_(L, 11, 12) CE_(L, 13, 14) CE_(L, 0, 8) CE_(L, 4, 12) CE_(L, 4, 8) CE_(L, 2, 10) CE_(L, 6, 14) CE_(L, 6, 10) CE_(L, 2, 4) CE_(L, 6, 8) CE_(L, 10, 12) CE_(L, 1, 9) CE_(L, 5, 13) CE_(L, 5, 9) CE_(L, 3, 11) CE_(L, 7, 15) CE_(L, 7, 11) CE_(L, 3, 5) CE_(L, 7, 9) CE_(L, 11, 13) CE_(L, 1, 2) CE_(L, 3, 4) CE_(L, 5, 6) CE_(L, 7, 8) CE_(L, 9, 10) CE_(L, 11, 12) CE_(L, 13, 14) } while (0)
#define BITONIC16_DESC(L) do { CE_(L, 0, 8) CE_(L, 1, 9) CE_(L, 2, 10) CE_(L, 3, 11) CE_(L, 4, 12) CE_(L, 5, 13) CE_(L, 6, 14) CE_(L, 7, 15) CE_(L, 0, 4) CE_(L, 1, 5) CE_(L, 2, 6) CE_(L, 3, 7) CE_(L, 8, 12) CE_(L, 9, 13) CE_(L, 10, 14) CE_(L, 11, 15) CE_(L, 0, 2) CE_(L, 1, 3) CE_(L, 4, 6) CE_(L, 5, 7) CE_(L, 8, 10) CE_(L, 9, 11) CE_(L, 12, 14) CE_(L, 13, 15) CE_(L, 0, 1) CE_(L, 2, 3) CE_(L, 4, 5) CE_(L, 6, 7) CE_(L, 8, 9) CE_(L, 10, 11) CE_(L, 12, 13) CE_(L, 14, 15) } while (0)
#define MERGE_TOP16(A, B) do { _Pragma("unroll") for (int i_ = 0; i_ < 16; ++i_) A[i_] = A[i_] > B[15 - i_] ? A[i_] : B[15 - i_]; BITONIC16_DESC(A); } while (0)
#define INS16(L, xin) do { unsigned _x = (xin); _Pragma("unroll") for (int _j = 0; _j < 16; ++_j) { const unsigned _h = L[_j] > _x ? L[_j] : _x; _x = L[_j] > _x ? _x : L[_j]; L[_j] = _h; } } while (0)
__device__ __forceinline__ void phase_router(const Frame& F, const bf16* q, const bf16* keys, unsigned char* Gm) {
    LAS v2u* ent = (LAS v2u*)F.lds;
    const int hi = F.lane >> 5, r32 = F.lane & 31, h = F.wave;
    for (int tb = F.vcu; tb < T / 32; tb += F.G) {
        const int t0 = tb * 32;
        { const v4u z = {0u, 0u, 0u, 0u}; unsigned char* zr = Gm + (size_t)(t0 + 4 * F.wave) * NE + 16 * F.lane;
#pragma unroll 1
            for (int k = 0; k < 4; ++k)
#pragma unroll
                for (int j = 0; j < 16; ++j) *(v4u*)(zr + (size_t)k * NE + 1024 * j) = z; }
        unsigned L[2][16];
#pragma unroll
        for (int i = 0; i < 2; ++i) {
            f32x16 acc[4];
#pragma unroll
            for (int mt = 0; mt < 4; ++mt)
#pragma unroll
                for (int r = 0; r < 16; ++r) acc[mt][r] = 0.f;
            const bf16* qrow = q + (size_t)(t0 + r32) * QW + h * 256 + i * 128 + 8 * hi;
            const bf16* krow = keys + ((size_t)((h * 2 + i) * 128 + r32)) * 128 + 8 * hi;
#pragma unroll 2
            for (int ks = 0; ks < 8; ++ks) { const bf16x8 bq = *(const bf16x8*)(qrow + 16 * ks);
#pragma unroll
                for (int mt = 0; mt < 4; ++mt) { const bf16x8 ak = *(const bf16x8*)(krow + mt * 4096 + 16 * ks);
                    acc[mt] = __builtin_amdgcn_mfma_f32_32x32x16_bf16(ak, bq, acc[mt], 0, 0, 0); } }
            const unsigned base = 127u - 4u * (unsigned)hi;
            unsigned G4[4][16];
#pragma unroll
            for (int mt = 0; mt < 4; ++mt)
#pragma unroll
                for (int r = 0; r < 16; ++r) G4[mt][r] = (ord_f(acc[mt][r]) & ~0x7fu) | (base - (unsigned)(32 * mt + 8 * (r >> 2) + (r & 3)));
            SORT16_DESC(G4[0]); SORT16_DESC(G4[1]); SORT16_DESC(G4[2]); SORT16_DESC(G4[3]);
            MERGE_TOP16(G4[0], G4[1]); MERGE_TOP16(G4[2], G4[3]); MERGE_TOP16(G4[0], G4[2]);
            unsigned Pn[16];
#pragma unroll
            for (int j = 0; j < 16; ++j) { L[i][j] = G4[0][j]; Pn[j] = (unsigned)__shfl_xor((int)G4[0][j], 32); }
            MERGE_TOP16(L[i], Pn);
        }
        float v0[16], v1[16];
#pragma unroll
        for (int j = 0; j < 16; ++j) { v0[j] = unord_f(L[0][j] & ~0x7fu); v1[j] = unord_f(L[1][j] & ~0x7fu); }
        unsigned C4[4][16];
        C4[0][0] = (ord_f(v0[0] + v1[0]) & ~0xffu) | 255u;
        C4[0][1] = (ord_f(v0[0] + v1[1]) & ~0xffu) | 254u;
        C4[0][2] = (ord_f(v0[0] + v1[2]) & ~0xffu) | 253u;
        C4[0][3] = (ord_f(v0[0] + v1[3]) & ~0xffu) | 252u;
        C4[0][4] = (ord_f(v0[0] + v1[4]) & ~0xffu) | 251u;
        C4[0][5] = (ord_f(v0[0] + v1[5]) & ~0xffu) | 250u;
        C4[0][6] = (ord_f(v0[0] + v1[6]) & ~0xffu) | 249u;
        C4[0][7] = (ord_f(v0[0] + v1[7]) & ~0xffu) | 248u;
        C4[0][8] = (ord_f(v0[0] + v1[8]) & ~0xffu) | 247u;
        C4[0][9] = (ord_f(v0[0] + v1[9]) & ~0xffu) | 246u;
        C4[0][10] = (ord_f(v0[0] + v1[10]) & ~0xffu) | 245u;
        C4[0][11] = (ord_f(v0[0] + v1[11]) & ~0xffu) | 244u;
        C4[0][12] = (ord_f(v0[0] + v1[12]) & ~0xffu) | 243u;
        C4[0][13] = (ord_f(v0[0] + v1[13]) & ~0xffu) | 242u;
        C4[0][14] = (ord_f(v0[0] + v1[14]) & ~0xffu) | 241u;
        C4[0][15] = (ord_f(v0[0] + v1[15]) & ~0xffu) | 240u;
        C4[1][0] = (ord_f(v0[1] + v1[0]) & ~0xffu) | 239u;
        C4[1][1] = (ord_f(v0[1] + v1[1]) & ~0xffu) | 238u;
        C4[1][2] = (ord_f(v0[1] + v1[2]) & ~0xffu) | 237u;
        C4[1][3] = (ord_f(v0[1] + v1[3]) & ~0xffu) | 236u;
        C4[1][4] = (ord_f(v0[1] + v1[4]) & ~0xffu) | 235u;
        C4[1][5] = (ord_f(v0[1] + v1[5]) & ~0xffu) | 234u;
        C4[1][6] = (ord_f(v0[1] + v1[6]) & ~0xffu) | 233u;
        C4[1][7] = (ord_f(v0[1] + v1[7]) & ~0xffu) | 232u;
        C4[1][8] = (ord_f(v0[2] + v1[0]) & ~0xffu) | 223u;
        C4[1][9] = (ord_f(v0[2] + v1[1]) & ~0xffu) | 222u;
        C4[1][10] = (ord_f(v0[2] + v1[2]) & ~0xffu) | 221u;
        C4[1][11] = (ord_f(v0[2] + v1[3]) & ~0xffu) | 220u;
        C4[1][12] = (ord_f(v0[2] + v1[4]) & ~0xffu) | 219u;
        C4[1][13] = (ord_f(v0[3] + v1[0]) & ~0xffu) | 207u;
        C4[1][14] = (ord_f(v0[3] + v1[1]) & ~0xffu) | 206u;
        C4[1][15] = (ord_f(v0[3] + v1[2]) & ~0xffu) | 205u;
        C4[2][0] = (ord_f(v0[3] + v1[3]) & ~0xffu) | 204u;
        C4[2][1] = (ord_f(v0[4] + v1[0]) & ~0xffu) | 191u;
        C4[2][2] = (ord_f(v0[4] + v1[1]) & ~0xffu) | 190u;
        C4[2][3] = (ord_f(v0[4] + v1[2]) & ~0xffu) | 189u;
        C4[2][4] = (ord_f(v0[5] + v1[0]) & ~0xffu) | 175u;
        C4[2][5] = (ord_f(v0[5] + v1[1]) & ~0xffu) | 174u;
        C4[2][6] = (ord_f(v0[6] + v1[0]) & ~0xffu) | 159u;
        C4[2][7] = (ord_f(v0[6] + v1[1]) & ~0xffu) | 158u;
        C4[2][8] = (ord_f(v0[7] + v1[0]) & ~0xffu) | 143u;
        C4[2][9] = (ord_f(v0[7] + v1[1]) & ~0xffu) | 142u;
        C4[2][10] = (ord_f(v0[8] + v1[0]) & ~0xffu) | 127u;
        C4[2][11] = (ord_f(v0[9] + v1[0]) & ~0xffu) | 111u;
        C4[2][12] = (ord_f(v0[10] + v1[0]) & ~0xffu) | 95u;
        C4[2][13] = (ord_f(v0[11] + v1[0]) & ~0xffu) | 79u;
        C4[2][14] = (ord_f(v0[12] + v1[0]) & ~0xffu) | 63u;
        C4[2][15] = (ord_f(v0[13] + v1[0]) & ~0xffu) | 47u;
        C4[3][0] = (ord_f(v0[14] + v1[0]) & ~0xffu) | 31u;
        C4[3][1] = (ord_f(v0[15] + v1[0]) & ~0xffu) | 15u;
        C4[3][2] = 0u;
        C4[3][3] = 0u;
        C4[3][4] = 0u;
        C4[3][5] = 0u;
        C4[3][6] = 0u;
        C4[3][7] = 0u;
        C4[3][8] = 0u;
        C4[3][9] = 0u;
        C4[3][10] = 0u;
        C4[3][11] = 0u;
        C4[3][12] = 0u;
        C4[3][13] = 0u;
        C4[3][14] = 0u;
        C4[3][15] = 0u;
        SORT16_DESC(C4[0]); SORT16_DESC(C4[1]); SORT16_DESC(C4[2]); SORT16_DESC(C4[3]);
        MERGE_TOP16(C4[0], C4[1]); MERGE_TOP16(C4[2], C4[3]); MERGE_TOP16(C4[0], C4[2]);
        unsigned M2[16];
#pragma unroll
        for (int j = 0; j < 16; ++j) M2[j] = C4[0][j];
        LAS unsigned char* idxrow = (LAS unsigned char*)(F.lds + 32768 + (F.wave * 64 + F.lane) * 32);
        { v4u p0, p1;
#pragma unroll
          for (int q = 0; q < 4; ++q) { p0[q] = (127u - (L[0][4 * q] & 0x7fu)) | ((127u - (L[0][4 * q + 1] & 0x7fu)) << 8) | ((127u - (L[0][4 * q + 2] & 0x7fu)) << 16) | ((127u - (L[0][4 * q + 3] & 0x7fu)) << 24);
                                        p1[q] = (127u - (L[1][4 * q] & 0x7fu)) | ((127u - (L[1][4 * q + 1] & 0x7fu)) << 8) | ((127u - (L[1][4 * q + 2] & 0x7fu)) << 16) | ((127u - (L[1][4 * q + 3] & 0x7fu)) << 24); }
          *(LAS v4u*)idxrow = p0; *(LAS v4u*)(idxrow + 16) = p1; }
        LDS_WAIT();
        float gate[16]; unsigned ex[16]; float gs = 0.f; const float mx = unord_f(M2[0] & ~0xffu);
#pragma unroll
        for (int k = 0; k < 16; ++k) { const unsigned flat = 255u - (M2[k] & 0xffu), a = flat >> 4, b = flat & 15u;
            ex[k] = (unsigned)idxrow[a] * 128u + (unsigned)idxrow[16 + b];
            gate[k] = exp_f(unord_f(M2[k] & ~0xffu) - mx); gs += gate[k]; }
        const float inv = 1.0f / gs;
        __syncthreads();
        if (hi == 0) {
#pragma unroll
            for (int k = 0; k < 16; ++k) { v2u e; e.x = ex[k]; e.y = __float_as_uint(gate[k] * inv); ent[r32 * 128 + h * 16 + k] = e; } }
        __syncthreads();
        LAS unsigned* bm = (LAS unsigned*)(F.lds + 49152 + F.wave * 2048);
        VM_WAIT();
        for (int tk = 0; tk < 4; ++tk) { const int tok = F.wave * 4 + tk; const LAS v2u* er = ent + tok * 128;
            { const v4u z = {0u, 0u, 0u, 0u}; *(LAS v4u*)(bm + 8 * F.lane) = z; *(LAS v4u*)(bm + 8 * F.lane + 4) = z; }
            LDS_WAIT();
            const v2u ea = er[F.lane], eb = er[F.lane + 64];
            const unsigned oa = __hip_atomic_fetch_or(bm + (ea.x >> 5), 1u << (ea.x & 31u), __ATOMIC_RELAXED, __HIP_MEMORY_SCOPE_WORKGROUP);
            const unsigned ob = __hip_atomic_fetch_or(bm + (eb.x >> 5), 1u << (eb.x & 31u), __ATOMIC_RELAXED, __HIP_MEMORY_SCOPE_WORKGROUP);
            const bool dup = (((oa >> (ea.x & 31u)) | (ob >> (eb.x & 31u))) & 1u) != 0u;
            unsigned char* grow = Gm + (size_t)(t0 + tok) * NE;
            if (__builtin_amdgcn_ballot_w64(dup) == 0ull) {
                grow[ea.x] = (unsigned char)(__builtin_amdgcn_cvt_pk_fp8_f32(__uint_as_float(ea.y) * PEER_GS, 0.f, 0, false) & 0xff);
                grow[eb.x] = (unsigned char)(__builtin_amdgcn_cvt_pk_fp8_f32(__uint_as_float(eb.y) * PEER_GS, 0.f, 0, false) & 0xff);
            } else {
                float ta = 0.f, tb2 = 0.f; bool fa = true, fb = true;
                for (int j = 0; j < 128; ++j) { const v2u ej = er[j]; const float gj = __uint_as_float(ej.y);
                    if (ej.x == ea.x) { ta += gj; if (j < F.lane) fa = false; }
                    if (ej.x == eb.x) { tb2 += gj; if (j < F.lane + 64) fb = false; } }
                if (fa) grow[ea.x] = (unsigned char)(__builtin_amdgcn_cvt_pk_fp8_f32(ta * PEER_GS, 0.f, 0, false) & 0xff);
                if (fb) grow[eb.x] = (unsigned char)(__builtin_amdgcn_cvt_pk_fp8_f32(tb2 * PEER_GS, 0.f, 0, false) & 0xff); } }
    }
}

constexpr int XP = 72;
__device__ __forceinline__ float softplus_f(float x) { return fmaxf(x, 0.f) + log1pf(__expf(-fabsf(x))); }
template <int NT> struct ConvIn { v4u raw[NT + 3]; f32x4 w[4][2]; f32x4 b[2]; };
template <int NT> __device__ __forceinline__ void conv_load(ConvIn<NT>& ci, const bf16* col, int t0, const float* cw, const float* cb) {
#pragma unroll
    for (int i = 0; i < NT + 3; ++i) { const int t = t0 - 3 + i; ci.raw[i] = (t >= 0) ? *(const v4u*)(col + (size_t)t * OD_INP) : (v4u){0u, 0u, 0u, 0u}; }
#pragma unroll
    for (int k = 0; k < 4; ++k) { ci.w[k][0] = *(const f32x4*)(cw + k * XBC); ci.w[k][1] = *(const f32x4*)(cw + k * XBC + 4); }
    ci.b[0] = *(const f32x4*)cb; ci.b[1] = *(const f32x4*)(cb + 4);
}
template <int NT> __device__ __forceinline__ void conv_compute(const ConvIn<NT>& ci, float (&y)[NT][8]) {
    float x0[8], x1[8], x2[8], x3[8];
    unpack8(ci.raw[0], x0); unpack8(ci.raw[1], x1); unpack8(ci.raw[2], x2);
#pragma unroll
    for (int i = 0; i < NT; ++i) { unpack8(ci.raw[i + 3], x3);
#pragma unroll
        for (int j = 0; j < 8; ++j) { y[i][j] = silu_f(ci.b[j >> 2][j & 3] + ci.w[0][j >> 2][j & 3] * x0[j] + ci.w[1][j >> 2][j & 3] * x1[j] + ci.w[2][j >> 2][j & 3] * x2[j] + ci.w[3][j >> 2][j & 3] * x3[j]); x0[j] = x1[j]; x1[j] = x2[j]; x2[j] = x3[j]; } }
}
__device__ __forceinline__ void conv_compute_packT(const ConvIn<8>& ci, const float (&wt)[8], v4u (&outp)[8]) {
    float x0[8], x1[8], x2[8], x3[8], ya[8], yb[8];
    unpack8(ci.raw[0], x0); unpack8(ci.raw[1], x1); unpack8(ci.raw[2], x2);
#pragma unroll
    for (int i = 0; i < 8; i += 2) {
        unpack8(ci.raw[i + 3], x3);
#pragma unroll
        for (int j = 0; j < 8; ++j) { ya[j] = wt[i] * silu_f(ci.b[j >> 2][j & 3] + ci.w[0][j >> 2][j & 3] * x0[j] + ci.w[1][j >> 2][j & 3] * x1[j] + ci.w[2][j >> 2][j & 3] * x2[j] + ci.w[3][j >> 2][j & 3] * x3[j]); x0[j] = x1[j]; x1[j] = x2[j]; x2[j] = x3[j]; }
        unpack8(ci.raw[i + 4], x3);
#pragma unroll
        for (int j = 0; j < 8; ++j) { yb[j] = wt[i + 1] * silu_f(ci.b[j >> 2][j & 3] + ci.w[0][j >> 2][j & 3] * x0[j] + ci.w[1][j >> 2][j & 3] * x1[j] + ci.w[2][j >> 2][j & 3] * x2[j] + ci.w[3][j >> 2][j & 3] * x3[j]); x0[j] = x1[j]; x1[j] = x2[j]; x2[j] = x3[j]; }
#pragma unroll
        for (int j = 0; j < 8; ++j) outp[j][i >> 1] = pk2(ya[j], yb[j]);
    }
}
template <int NT> __device__ __forceinline__ void conv_silu_run(const bf16* col, int t0, const float* cw, const float* cb, float (&y)[NT][8]) {
    ConvIn<NT> ci; conv_load<NT>(ci, col, t0, cw, cb); conv_compute<NT>(ci, y);
}
__device__ __forceinline__ float wave_incl_scan(float v, int lane) {
#pragma unroll
    for (int o = 1; o < 64; o <<= 1) { const float t = __shfl_up(v, o); v = (lane >= o) ? v + t : v; }
    return v;
}
__device__ __forceinline__ void dt_acs(const bf16* proj, int t0, int h, const float* dt_bias, const float* a_log, int lane, float& dt, float& acs) {
    dt = softplus_f(bf2f(proj[(size_t)(t0 + lane) * OD_INP + 18432 + h]) + dt_bias[h]);
    acs = wave_incl_scan(dt * (-__expf(a_log[h])), lane);
}
constexpr float SSD_LS = 16.0f;
__device__ __forceinline__ unsigned fp8x4_sat(const f32x4 v, float sc) { int w = 0; w = __builtin_amdgcn_cvt_pk_fp8_f32(__builtin_amdgcn_fmed3f(v[0] * sc, -448.f, 448.f), __builtin_amdgcn_fmed3f(v[1] * sc, -448.f, 448.f), w, false);
    w = __builtin_amdgcn_cvt_pk_fp8_f32(__builtin_amdgcn_fmed3f(v[2] * sc, -448.f, 448.f), __builtin_amdgcn_fmed3f(v[3] * sc, -448.f, 448.f), w, true); return (unsigned)w; }
__device__ __forceinline__ void phase_ssd_s1(const Frame& F, const bf16* proj, const float* conv_w, const float* conv_b, const float* dt_bias, const float* a_log, unsigned char* st, float* aendb) {
    LAS bf16* BT = (LAS bf16*)F.lds;
    LAS bf16* xwT = (LAS bf16*)(F.lds + 18432 + F.wave * 9216);
    LAS float* wgtw = (LAS float*)(F.lds + 18432 + 8 * 9216 + F.wave * 256);
    for (int u = F.vcu; u < (T / 64) * 8; u += F.G) {
        const int c = u >> 3, g = u & 7, t0 = c * 64;
        int lane_o = F.lane; asm volatile("" : "+v"(lane_o));
        const int fr = lane_o & 15, fq = lane_o >> 4, tid_o = F.wave * 64 + lane_o;
        __syncthreads();
        if (tid_o < 256) { const int ng = tid_o & 15, lg = tid_o >> 4, ch = 8192 + g * 128 + ng * 8; float y[4][8];
            conv_silu_run<4>(proj + 8192 + ch, t0 + 4 * lg, conv_w + ch, conv_b + ch, y);
#pragma unroll
            for (int j = 0; j < 8; ++j) { const int n = ng * 8 + j, slot = (n & ~31) + 16 * ((n >> 2) & 1) + 4 * ((n >> 3) & 3) + (n & 3);
                v2u o; o.x = pk2(y[0][j], y[1][j]); o.y = pk2(y[2][j], y[3][j]); *(LAS v2u*)(BT + slot * XP + 4 * lg) = o; } }
        __syncthreads();
#pragma unroll 1
        for (int hh = 0; hh < 2; ++hh) {
            const int h = g * 16 + 2 * F.wave + hh, pg = lane_o & 7, l8 = lane_o >> 3, chx = h * 64 + pg * 8;
            const bf16 dtraw = proj[(size_t)(t0 + lane_o) * OD_INP + 18432 + h]; const float dtb = dt_bias[h], alg = a_log[h];
            ConvIn<8> ci; conv_load<8>(ci, proj + 8192 + chx, t0 + 8 * l8, conv_w + chx, conv_b + chx);
            { const float dt = softplus_f(bf2f(dtraw) + dtb), ac = wave_incl_scan(dt * (-__expf(alg)), lane_o), aend = __shfl(ac, 63);
              wgtw[lane_o] = dt * exp_f(aend - ac);
              if (lane_o == 63) aendb[c * NHEAD + h] = aend; }
            LDS_WAIT();
            { const f32x4 wa = *(const LAS f32x4*)(wgtw + 8 * l8), wb = *(const LAS f32x4*)(wgtw + 8 * l8 + 4); const float wt[8] = {wa[0], wa[1], wa[2], wa[3], wb[0], wb[1], wb[2], wb[3]};
              v4u outp[8]; conv_compute_packT(ci, wt, outp);
#pragma unroll
              for (int j = 0; j < 8; ++j) *(LAS v4u*)(xwT + (pg * 8 + j) * XP + 8 * l8) = outp[j]; }
            LDS_WAIT();
            unsigned char* so = st + ((size_t)(c * NHEAD + h) * 64) * 128;
#pragma unroll
            for (int nh = 0; nh < 2; ++nh) {
                f32x4 acc[4][4];
#pragma unroll
                for (int a = 0; a < 4; ++a)
#pragma unroll
                    for (int b = 0; b < 4; ++b) acc[a][b] = (f32x4){0.f, 0.f, 0.f, 0.f};
#pragma unroll
                for (int ks = 0; ks < 2; ++ks) { bf16x8 af[4];
#pragma unroll
                    for (int pt = 0; pt < 4; ++pt) af[pt] = *(const LAS bf16x8*)(xwT + (16 * pt + fr) * XP + 32 * ks + 8 * fq);
#pragma unroll
                    for (int n4 = 0; n4 < 4; ++n4) { const bf16x8 bfr = *(const LAS bf16x8*)(BT + (16 * (4 * nh + n4) + fr) * XP + 32 * ks + 8 * fq);
#pragma unroll
                        for (int pt = 0; pt < 4; ++pt) acc[pt][n4] = __builtin_amdgcn_mfma_f32_16x16x32_bf16(bfr, af[pt], acc[pt][n4], 0, 0, 0); } }
#pragma unroll
                for (int pt = 0; pt < 4; ++pt)
#pragma unroll
                    for (int k2 = 0; k2 < 2; ++k2) { v2u o; o.x = fp8x4_sat(acc[pt][2 * k2], SSD_LS); o.y = fp8x4_sat(acc[pt][2 * k2 + 1], SSD_LS);
                        *(v2u*)(so + (size_t)(16 * pt + fr) * 128 + 32 * (2 * nh + k2) + 8 * fq) = o; }
            }
            LDS_WAIT();
        }
    }
}
constexpr float SSD_SS = 4.0f;
__device__ __forceinline__ void phase_ssd_scan(const Frame& F, const unsigned char* loc, unsigned char* st, const float* aendb) {
    constexpr size_t CS = (size_t)NHEAD * 64 * 128;
    for (int it = F.vcu * 512 + F.tid; it < NHEAD * 64 * 16; it += F.G * 512) {
        const int h = it >> 10; unsigned char* base = st + (size_t)it * 8; const unsigned char* lbase = loc + (size_t)it * 8;
        float s[8];
#pragma unroll
        for (int j = 0; j < 8; ++j) s[j] = 0.f;
        v2u cur[8], nxt[8]; float dcur[8], dnxt[8];
#pragma unroll
        for (int k = 0; k < 8; ++k) { cur[k] = *(const v2u*)(lbase + (size_t)k * CS); dcur[k] = aendb[k * NHEAD + h]; }
#pragma unroll 1
        for (int c0 = 0; c0 < 256; c0 += 8) {
            if (c0 + 8 < 256) {
#pragma unroll
                for (int k = 0; k < 8; ++k) { nxt[k] = *(const v2u*)(lbase + (size_t)(c0 + 8 + k) * CS); dnxt[k] = aendb[(c0 + 8 + k) * NHEAD + h]; } }
            asm volatile("" ::: "memory");
#pragma unroll
            for (int k = 0; k < 8; ++k) { { const f32x4 sa = {s[0], s[1], s[2], s[3]}, sb = {s[4], s[5], s[6], s[7]}; v2u o; o.x = fp8x4_sat(sa, SSD_SS); o.y = fp8x4_sat(sb, SSD_SS); *(v2u*)(base + (size_t)(c0 + k) * CS) = o; } const float dec = exp_f(dcur[k]); const int w0 = (int)cur[k].x, w1 = (int)cur[k].y;
                const float lv[8] = {__builtin_amdgcn_cvt_f32_fp8(w0, 0), __builtin_amdgcn_cvt_f32_fp8(w0, 1), __builtin_amdgcn_cvt_f32_fp8(w0, 2), __builtin_amdgcn_cvt_f32_fp8(w0, 3),
                                     __builtin_amdgcn_cvt_f32_fp8(w1, 0), __builtin_amdgcn_cvt_f32_fp8(w1, 1), __builtin_amdgcn_cvt_f32_fp8(w1, 2), __builtin_amdgcn_cvt_f32_fp8(w1, 3)};
#pragma unroll
                for (int j = 0; j < 8; ++j) s[j] = s[j] * dec + lv[j] * (1.0f / SSD_LS); }
            asm volatile("" ::: "memory");
#pragma unroll
            for (int k = 0; k < 8; ++k) { cur[k] = nxt[k]; dcur[k] = dnxt[k]; }
        }
    }
}
__device__ __forceinline__ void phase_ssd_out(const Frame& F, const bf16* proj, const float* conv_w, const float* conv_b, const float* dt_bias, const float* a_log, const unsigned char* st, const float* dskip, const float* norm_g, bf16* yn, unsigned char* yn8) {
    constexpr int CP = 136, CBP = 68;
    LAS bf16* Csm = (LAS bf16*)F.lds; LAS bf16* Bsm = (LAS bf16*)(F.lds + 17408); LAS float* cb = (LAS float*)(F.lds + 34816); LAS float* red = (LAS float*)(F.lds + 52224);
    LAS float* acsw = (LAS float*)(F.lds + 54272 + F.wave * 512); LAS float* dtw = acsw + 64;
    LAS bf16* xT = (LAS bf16*)(F.lds + 58368 + F.wave * 9216);
    for (int u = F.vcu; u < (T / 64) * 8; u += F.G) {
        const int c = u >> 3, g = u & 7, t0 = c * 64;
        int lane_o; asm volatile("v_mbcnt_lo_u32_b32 %0, -1, 0\n\tv_mbcnt_hi_u32_b32 %0, -1, %0" : "=&v"(lane_o));
        const int fr = lane_o & 15, fq = lane_o >> 4, tid_o = F.wave * 64 + lane_o;
        __syncthreads();
        { const int tl = tid_o & 255, seg = tl & 15, lg = tl >> 4, isC = tid_o >> 8, ch = 8192 + isC * 1024 + g * 128 + seg * 8; float y[4][8];
          conv_silu_run<4>(proj + 8192 + ch, t0 + 4 * lg, conv_w + ch, conv_b + ch, y);
          LAS bf16* dstm = isC ? Csm : Bsm;
#pragma unroll
          for (int i = 0; i < 4; ++i) *(LAS v4u*)(dstm + (4 * lg + i) * CP + seg * 8) = pack8(y[i]); }
        __syncthreads();
        { const int lt = F.wave >> 1;
#pragma unroll
          for (int si = 0; si < 2; ++si) { const int stt = 2 * (F.wave & 1) + si; f32x4 a = (f32x4){0.f, 0.f, 0.f, 0.f};
#pragma unroll
              for (int ks = 0; ks < 4; ++ks) { const bf16x8 bfr = *(const LAS bf16x8*)(Bsm + (16 * stt + fr) * CP + 32 * ks + 8 * fq), af = *(const LAS bf16x8*)(Csm + (16 * lt + fr) * CP + 32 * ks + 8 * fq);
                  a = __builtin_amdgcn_mfma_f32_16x16x32_bf16(bfr, af, a, 0, 0, 0); }
              *(LAS f32x4*)(cb + (16 * lt + fr) * CBP + 16 * stt + 4 * fq) = a; } }
        __syncthreads();
        float ssq[4] = {0.f, 0.f, 0.f, 0.f};
        v2u ypk[2][4][4];
#pragma unroll
        for (int hh = 0; hh < 2; ++hh) {
            const int h = g * 16 + 2 * F.wave + hh; const unsigned char* sp = st + ((size_t)(c * NHEAD + h) * 64) * 128;
            const int pg = lane_o & 7, l8 = lane_o >> 3, chx = h * 64 + pg * 8;
            const bf16 dtraw = proj[(size_t)(t0 + lane_o) * OD_INP + 18432 + h]; const float dtb = dt_bias[h], alg = a_log[h];
            ConvIn<8> ci; conv_load<8>(ci, proj + 8192 + chx, t0 + 8 * l8, conv_w + chx, conv_b + chx);
            v2u sf[4][4];
            asm volatile("" ::: "memory");
            { const float dt = softplus_f(bf2f(dtraw) + dtb), ac = wave_incl_scan(dt * (-__expf(alg)), lane_o); acsw[lane_o] = ac; dtw[lane_o] = dt; }
            LDS_WAIT();
            { const f32x4 wa = *(const LAS f32x4*)(dtw + 8 * l8), wb = *(const LAS f32x4*)(dtw + 8 * l8 + 4); const float wt[8] = {wa[0], wa[1], wa[2], wa[3], wb[0], wb[1], wb[2], wb[3]};
              v4u outp[8]; conv_compute_packT(ci, wt, outp);
#pragma unroll
              for (int j = 0; j < 8; ++j) *(LAS v4u*)(xT + (pg * 8 + j) * XP + 8 * l8) = outp[j]; }
            asm volatile("" ::: "memory");
#pragma unroll
            for (int ks = 0; ks < 4; ++ks)
#pragma unroll
                for (int pt = 0; pt < 4; ++pt) sf[ks][pt] = *(const v2u*)(sp + (size_t)(16 * pt + fr) * 128 + 32 * ks + 8 * fq);
            LDS_WAIT();
            f32x4 acc[4][4];
#pragma unroll
            for (int a = 0; a < 4; ++a)
#pragma unroll
                for (int b = 0; b < 4; ++b) acc[a][b] = (f32x4){0.f, 0.f, 0.f, 0.f};
#pragma unroll
            for (int ks = 0; ks < 4; ++ks) { bf16x8 sb[4];
#pragma unroll
                for (int pt = 0; pt < 4; ++pt) { const int w0 = (int)sf[ks][pt].x, w1 = (int)sf[ks][pt].y; const pg8::f32x2c a = __builtin_amdgcn_cvt_pk_f32_fp8(w0, false), b = __builtin_amdgcn_cvt_pk_f32_fp8(w0, true), c2 = __builtin_amdgcn_cvt_pk_f32_fp8(w1, false), d = __builtin_amdgcn_cvt_pk_f32_fp8(w1, true);
                    v4u o; o.x = pk2(a[0], a[1]); o.y = pk2(b[0], b[1]); o.z = pk2(c2[0], c2[1]); o.w = pk2(d[0], d[1]); sb[pt] = __builtin_bit_cast(bf16x8, o); }
#pragma unroll
                for (int lt = 0; lt < 4; ++lt) { const bf16x8 cf = *(const LAS bf16x8*)(Csm + (16 * lt + fr) * CP + 32 * ks + 8 * fq);
#pragma unroll
                    for (int pt = 0; pt < 4; ++pt) acc[lt][pt] = __builtin_amdgcn_mfma_f32_16x16x32_bf16(sb[pt], cf, acc[lt][pt], 0, 0, 0); } }
#pragma unroll
            for (int lt = 0; lt < 4; ++lt) { const float el = exp_f(acsw[16 * lt + fr]) * (1.0f / SSD_SS);
#pragma unroll
                for (int pt = 0; pt < 4; ++pt) acc[lt][pt] *= el; }
            const float dh = dskip[h];
#pragma unroll
            for (int ks = 0; ks < 2; ++ks) { bf16x8 xf[4];
#pragma unroll
                for (int pt = 0; pt < 4; ++pt) xf[pt] = *(const LAS bf16x8*)(xT + (16 * pt + fr) * XP + 32 * ks + 8 * fq);
#pragma unroll
                for (int lt = 0; lt < 4; ++lt) { if (32 * ks > 16 * lt + 15) continue;
                    const int l = 16 * lt + fr, s0 = 32 * ks + 8 * fq; const float al = acsw[l], dinv = dh / dtw[l];
                    const f32x4 ca = *(const LAS f32x4*)(cb + l * CBP + s0), cbb = *(const LAS f32x4*)(cb + l * CBP + s0 + 4);
                    const f32x4 sa = *(const LAS f32x4*)(acsw + s0), sb = *(const LAS f32x4*)(acsw + s0 + 4);
                    float mv[8];
#pragma unroll
                    for (int j = 0; j < 4; ++j) { mv[j] = (s0 + j <= l) ? ca[j] * exp_f(al - sa[j]) : 0.f; mv[4 + j] = (s0 + 4 + j <= l) ? cbb[j] * exp_f(al - sb[j]) : 0.f;
                        mv[j] += (s0 + j == l) ? dinv : 0.f; mv[4 + j] += (s0 + 4 + j == l) ? dinv : 0.f; }
                    const v4u mp = pack8(mv); const bf16x8 mf = __builtin_bit_cast(bf16x8, mp);
#pragma unroll
                    for (int pt = 0; pt < 4; ++pt) acc[lt][pt] = __builtin_amdgcn_mfma_f32_16x16x32_bf16(xf[pt], mf, acc[lt][pt], 0, 0, 0); } }
            v2u zreg[4][4];
#pragma unroll
            for (int lt = 0; lt < 4; ++lt)
#pragma unroll
                for (int pt = 0; pt < 4; ++pt) zreg[lt][pt] = *(const v2u*)(proj + (size_t)(t0 + 16 * lt + fr) * OD_INP + h * 64 + 16 * pt + 4 * fq);
#pragma unroll
            for (int lt = 0; lt < 4; ++lt) {
#pragma unroll
                for (int pt = 0; pt < 4; ++pt) { const v2u zv = zreg[lt][pt];
                    const float y0 = acc[lt][pt][0] * silu_f(bflo(zv.x)), y1 = acc[lt][pt][1] * silu_f(bfhi(zv.x)), y2 = acc[lt][pt][2] * silu_f(bflo(zv.y)), y3 = acc[lt][pt][3] * silu_f(bfhi(zv.y));
                    ssq[lt] += (y0 * y0 + y1 * y1) + (y2 * y2 + y3 * y3);
                    ypk[hh][lt][pt].x = pk2(y0, y1); ypk[hh][lt][pt].y = pk2(y2, y3); } }
            LDS_WAIT();
        }
#pragma unroll
        for (int lt = 0; lt < 4; ++lt) { float s = ssq[lt]; s += __shfl_xor(s, 16); s += __shfl_xor(s, 32); if (fq == 0) red[F.wave * 64 + 16 * lt + fr] = s; }
        __syncthreads();
        if (tid_o < 64) { float tot = 0.f;
#pragma unroll
            for (int w = 0; w < 8; ++w) tot += red[w * 64 + tid_o];
            cb[tid_o] = 1.0f / sqrtf(tot * (1.0f / 1024.0f) + EPS); }
        __syncthreads();
#pragma unroll
        for (int hh = 0; hh < 2; ++hh) { const int h = g * 16 + 2 * F.wave + hh;
#pragma unroll
            for (int pt = 0; pt < 4; ++pt) { const int ch = h * 64 + 16 * pt + 4 * fq; const f32x4 ga = *(const f32x4*)(norm_g + ch);
#pragma unroll
                for (int lt = 0; lt < 4; ++lt) { const float rs = cb[16 * lt + fr]; const v2u yv = ypk[hh][lt][pt];
                    int o = 0; o = __builtin_amdgcn_cvt_pk_fp8_f32(bflo(yv.x) * rs * ga[0], bfhi(yv.x) * rs * ga[1], o, false); o = __builtin_amdgcn_cvt_pk_fp8_f32(bflo(yv.y) * rs * ga[2], bfhi(yv.y) * rs * ga[3], o, true);
                    *(unsigned*)(yn8 + tiled_off(t0 + 16 * lt + fr, ch >> 7, SSM_INNER / 128, (ch & 127) & ~15, false) + (ch & 15)) = (unsigned)o; } } }
    }
}

#ifdef DBG_PROBE
__device__ __forceinline__ void dbg_probe_bf16(const Frame& F, const bf16* buf, size_t ld, int width, float* out) {
    const int gw = F.vcu * 8 + F.wave, NGW = F.G * 8;
    for (int m = gw; m < T; m += NGW) for (int c = F.lane; c < D; c += 64) { float s = 0.f; for (int k = c; k < width; k += D) s += bf2f(buf[(size_t)m * ld + k]); out[(size_t)m * D + c] = s; }
}
__device__ __forceinline__ void dbg_probe_f32(const Frame& F, const float* buf, size_t ld, int width, float* out) {
    const int gw = F.vcu * 8 + F.wave, NGW = F.G * 8;
    for (int m = gw; m < T; m += NGW) for (int c = F.lane; c < D; c += 64) { float s = 0.f; for (int k = c; k < width; k += D) s += buf[(size_t)m * ld + k]; out[(size_t)m * D + c] += s; }
}
#endif
struct Params { const float* in[22]; float* out; unsigned char* ws; int ph_lo, ph_hi; };
#ifndef PH_MASK
#define PH_MASK 0xFFFFFFFFu
#endif
typedef const __attribute__((address_space(4))) Params* KArgs;
#ifndef MK_ONE_LAUNCH
#define MK_ONE_LAUNCH 1
#endif
__global__ void __launch_bounds__(512, 2) mega_fwd(Params P) {
    extern __shared__ __attribute__((aligned(16))) unsigned char lds_raw[];
    Frame F0; F0.lds = (LAS unsigned char*)lds_raw; F0.tid = threadIdx.x; F0.lane = F0.tid & 63; F0.wave = __builtin_amdgcn_readfirstlane(F0.tid >> 6);
    F0.G = NCU; { const int bx = blockIdx.x; F0.vcu = (bx % 8) * (NCU / 8) + bx / 8; }
#define FRAME() Frame F = F0; { int l_; asm volatile("v_mbcnt_lo_u32_b32 %0, -1, 0\n\tv_mbcnt_hi_u32_b32 %0, -1, %0" : "=&v"(l_)); F.lane = l_; F.tid = F0.wave * 64 + l_; } \
    KArgs A_ = (KArgs)__builtin_amdgcn_kernarg_segment_ptr(); asm volatile("" : "+s"(A_));     \
    unsigned char* const ws = A_->ws; float* const hres = A_->out; \
    int bid = (int)blockIdx.x; asm volatile("" : "+s"(bid)); F.vcu = (bid % 8) * (NCU / 8) + bid / 8;
    volatile LAS unsigned* MISC = (volatile LAS unsigned*)(F0.lds + MISC_OFF);
    if (F0.tid < 32) MISC[F0.tid] = 0u;
    __syncthreads();
    const int lo = P.ph_lo, hi = P.ph_hi;
    XcdBarrier bar; bar.bar = (unsigned*)(P.ws + WS_CTL) + CW_BAR; bar.x = 0; bar.st = nullptr;
    if (hi - lo > 1) bar = xcd_barrier_post((unsigned*)(P.ws + WS_CTL) + CW_BAR, MISC + 8, F0.tid);
#ifdef DUP_MASK
#define DUPLOOP(k) for (int rp_ = 0; rp_ <= (int)((DUP_MASK >> (k)) & 1u); ++rp_)
#else
#define DUPLOOP(k)
#endif
#define IN(k) (((PH_MASK >> (k)) & 1u) && lo <= (k) && (k) < hi)
#define SEAM(k) do { if (lo <= (k) && (k) + 1 < hi) { FRAME(); xcd_barrier(bar, F.tid); } } while (0)
#define X_IN (A_->in[0])
#define mix_norm (A_->in[1])
#define ffn_norm (A_->in[2])
#define final_norm (A_->in[3])
#define keysb ((bf16*)(ws + WS_KEYS))
#define hn ((bf16*)(ws + WS_HN))
#define proj ((bf16*)(ws + WS_PROJ))
#define ycat ((bf16*)(ws + WS_YCAT))
#define qb ((bf16*)(ws + WS_Q))
#define Gm (ws + WS_G)
#define hn8 (ws + WS_HN8)
#define aendb ((float*)(ws + WS_AEND))
#define hb ((bf16*)(ws + WS_HB))
#define rstdb ((float*)(ws + WS_HB + 128 * MiB))
#define state ((bf16*)(ws + WS_STATE))

    if (IN(0)) DUPLOOP(0) { FRAME();
        transpose_matrix(F, A_->in[4], D, EV_IN, (bf16*)(ws + WS_WIN0), 2);
        transpose_matrix(F, A_->in[9], D, D, (bf16*)(ws + WS_WOUT0), 1);
        transpose_matrix(F, A_->in[18], D, QW, (bf16*)(ws + WS_WQ0), 2, ffn_norm);
        transpose_matrix_fp6(F, A_->in[21], NE, D, ws + WS_V0, PEER_V6, true);
        convert_matrix_fp6(F, A_->in[20], ws + WS_U0, D, (size_t)NE * D / 32, PEER_U6);
        convert_matrix(F, A_->in[19], keysb, (size_t)2 * 8 * 2 * 128 * 128 / 8);
        rms_rows_bf16<false>(F, X_IN, mix_norm, hn);
    }
    SEAM(0);
    if (IN(1)) DUPLOOP(1) { FRAME(); { pg8::Gemm g{hn, (bf16*)(ws + WS_WIN0), T, EV_IN, D}; pg8::StaticOrder S; S.init(T, EV_IN, F.G, bid); pg8::EpiBf16G E{proj, EV_IN, 24, 1.0f};
        pg8::gemm_phase<pg8::EpiBf16G, pg8::StaticOrder, true, true, false, 0, false, true>(F.lds, g, S, E, F.tid); } }
    SEAM(1);
    if (IN(2)) DUPLOOP(2) { FRAME(); phase_conv_sgu(F, proj, A_->in[5], A_->in[6], A_->in[7], A_->in[8], ycat); }
    SEAM(2);
    if (IN(3)) DUPLOOP(3) { FRAME(); { pg8::Gemm g{ycat, (bf16*)(ws + WS_WOUT0), T, D, D}; pg8::StaticOrder S; S.init(T, D, F.G, bid); pg8::EpiRes<false, true> E{X_IN, hb, D, 1.0f};
        pg8::gemm_phase<pg8::EpiRes<false, true>, pg8::StaticOrder, true, true, false, 0, false, true>(F.lds, g, S, E, F.tid); } }
    SEAM(3);
    if (IN(4)) DUPLOOP(4) { FRAME(); rms_rows_bf16<true>(F, hb, ffn_norm, nullptr, nullptr, hn8, PEER_A6, rstdb); }
    SEAM(4);
    if (IN(5)) DUPLOOP(5) { FRAME(); { pg8::Gemm g{hb, (bf16*)(ws + WS_WQ0), T, QW, D}; pg8::StaticOrder S; S.init(T, QW, F.G, bid); pg8::EpiBf16G E{qb, QW, 1 << 30, 1.0f, rstdb};
        pg8::gemm_phase<pg8::EpiBf16G, pg8::StaticOrder, true, true, false, 0, false, true>(F.lds, g, S, E, F.tid); } }
    SEAM(5);
    if (IN(6)) DUPLOOP(6) { FRAME(); phase_router(F, qb, keysb, Gm); }
    SEAM(6);
    if (IN(7)) DUPLOOP(7) { FRAME(); { pg8::Gemm g{(const bf16*)hn8, (const bf16*)(ws + WS_U0), T, NE, D / 2}; pg8::StaticOrder S; S.init(T, NE, F.G, bid); pg8::EpiPeerU8 E{Gm, NE, 1.0f / (PEER_U6 * PEER_A6)};
        pg8::gemm_phase<pg8::EpiPeerU8, pg8::StaticOrder, true, true, true, 2>(F.lds, g, S, E, F.tid); } }
    SEAM(7);
    if (IN(8)) DUPLOOP(8) { FRAME(); { pg8::Gemm g{(const bf16*)Gm, (const bf16*)(ws + WS_V0), T, D, NE / 2}; pg8::StaticOrder S; S.init(T, D, F.G, bid); S.wgm = 4; pg8::EpiRes<true, true> E{hb, hb, D, 1.0f / (PEER_GS * PEER_V6)};
        pg8::gemm_phase<pg8::EpiRes<true, true>, pg8::StaticOrder, true, true, true, 3>(F.lds, g, S, E, F.tid); } }
    SEAM(8);
    if (IN(9)) DUPLOOP(9) { FRAME();
        transpose_matrix_fp6(F, A_->in[10], D, OD_IN, ws + WS_WIN1, PEER_U6);
        zero_bytes(F, ws + WS_WIN1 + (size_t)OD_IN * (D * 3 / 4), (size_t)(OD_INP - OD_IN) * (D * 3 / 4) / 16);
        transpose_matrix_fp6(F, A_->in[17], SSM_INNER, D, ws + WS_WOUT1, OUT1_W6, true);
        transpose_matrix(F, A_->in[18] + (size_t)D * QW, D, QW, (bf16*)(ws + WS_WQ1), 2, ffn_norm + D);
        transpose_matrix_fp6(F, A_->in[21] + (size_t)NE * D, NE, D, ws + WS_V1, PEER_V6, true);
        convert_matrix_fp6(F, A_->in[20] + (size_t)NE * D, ws + WS_U1, D, (size_t)NE * D / 32, PEER_U6);
        rms_rows_bf16<true>(F, hb, mix_norm + D, nullptr, nullptr, hn8, PEER_A6);
    }
    SEAM(9);
    if (IN(10)) DUPLOOP(10) { FRAME(); { pg8::Gemm g{(const bf16*)hn8, (const bf16*)(ws + WS_WIN1), T, OD_INP, D / 2}; pg8::StaticOrder S; S.init(T, OD_INP, F.G, bid); pg8::EpiBf16G E{proj, OD_INP, 1 << 30, 1.0f / (PEER_U6 * PEER_A6)};
        pg8::gemm_phase<pg8::EpiBf16G, pg8::StaticOrder, true, true, true, 2>(F.lds, g, S, E, F.tid); } }
    SEAM(10);
    if (IN(11)) DUPLOOP(11) { FRAME(); phase_ssd_s1(F, proj, A_->in[11], A_->in[12], A_->in[13], A_->in[14], (unsigned char*)ycat, aendb); }
    SEAM(11);
    if (IN(12)) DUPLOOP(12) { FRAME(); phase_ssd_scan(F, (const unsigned char*)ycat, (unsigned char*)state, aendb); }
    SEAM(12);
    if (IN(13)) DUPLOOP(13) { FRAME(); phase_ssd_out(F, proj, A_->in[11], A_->in[12], A_->in[13], A_->in[14], (const unsigned char*)state, A_->in[15], A_->in[16], ycat, (unsigned char*)hn); }
    SEAM(13);
    if (IN(14)) { FRAME(); { pg8::Gemm g{(const bf16*)hn, (const bf16*)(ws + WS_WOUT1), T, D, SSM_INNER / 2}; pg8::StaticOrder S; S.init(T, D, F.G, bid); pg8::EpiRes<true, true> E{hb, hb, D, 1.0f / OUT1_W6};
        pg8::gemm_phase<pg8::EpiRes<true, true>, pg8::StaticOrder, true, true, true, 3, true, false>(F.lds, g, S, E, F.tid); } }
    SEAM(14);
    if (IN(15)) DUPLOOP(15) { FRAME(); { rms_rows_bf16<true>(F, hb, ffn_norm + D, nullptr, nullptr, hn8, PEER_A6, rstdb); } }
    SEAM(15);
    if (IN(16)) DUPLOOP(16) { FRAME(); { pg8::Gemm g{hb, (bf16*)(ws + WS_WQ1), T, QW, D}; pg8::StaticOrder S; S.init(T, QW, F.G, bid); pg8::EpiBf16G E{qb, QW, 1 << 30, 1.0f, rstdb};
        pg8::gemm_phase<pg8::EpiBf16G, pg8::StaticOrder, true, true, false, 0, false, true>(F.lds, g, S, E, F.tid); } }
    SEAM(16);
    if (IN(17)) DUPLOOP(17) { FRAME(); phase_router(F, qb, keysb + (size_t)8 * 2 * 128 * 128, Gm); }
    SEAM(17);
    if (IN(18)) DUPLOOP(18) { FRAME(); { pg8::Gemm g{(const bf16*)hn8, (const bf16*)(ws + WS_U1), T, NE, D / 2}; pg8::StaticOrder S; S.init(T, NE, F.G, bid); pg8::EpiPeerU8 E{Gm, NE, 1.0f / (PEER_U6 * PEER_A6)};
        pg8::gemm_phase<pg8::EpiPeerU8, pg8::StaticOrder, true, true, true, 2>(F.lds, g, S, E, F.tid); } }
    SEAM(18);
    if (IN(19)) DUPLOOP(19) { FRAME(); { pg8::Gemm g{(const bf16*)Gm, (const bf16*)(ws + WS_V1), T, D, NE / 2}; pg8::StaticOrder S; S.init(T, D, F.G, bid); S.wgm = 4; pg8::EpiRes<true, true> E{hb, hb, D, 1.0f / (PEER_GS * PEER_V6)};
        pg8::gemm_phase<pg8::EpiRes<true, true>, pg8::StaticOrder, true, true, true, 3>(F.lds, g, S, E, F.tid); } }
    SEAM(19);
#ifdef DBG_PROBE
    if (lo == 20) { FRAME();
        if (DBG_PROBE == 3) dbg_probe_bf16(F, state, D, D, hres);
        if (DBG_PROBE == 4) dbg_probe_bf16(F, ycat, SSM_INNER, 2048, hres);
        if (DBG_PROBE == 5) dbg_probe_bf16(F, proj, OD_INP, OD_IN, hres);
    }
#endif
    if (IN(20)) DUPLOOP(20) { FRAME(); rms_rows_final(F, hb, final_norm, hres); }
#undef IN
#undef SEAM
#undef X_IN
#undef mix_norm
#undef ffn_norm
#undef final_norm
#undef keysb
#undef hn
#undef proj
#undef ycat
#undef qb
#undef Gm
#undef hn8
#undef aendb
#undef hb
#undef rstdb
#undef state
}
__global__ void fill_zero(float* o, int n) { for (int i = blockIdx.x * blockDim.x + threadIdx.x; i < n; i += gridDim.x * blockDim.x) o[i] = 0.f; }

extern "C" void kernel_launch(void* const* d_in, const int* in_sizes, int n_in, void* d_out, int out_size, void* d_ws, size_t ws_size, hipStream_t stream) {
    static int grid = 0;
    if (grid == 0) {
        if (n_in != 22 || out_size != T * D || ws_size < WS_END) { fprintf(stderr, "kernel_launch: unexpected shapes (n_in %d, out %d, ws %zu < %zu)\n", n_in, out_size, ws_size, (size_t)WS_END); grid = -1; }
        else {
            int dev = 0, cus = 0, per_cu = 0;
            if (hipGetDevice(&dev) != hipSuccess || hipDeviceGetAttribute(&cus, hipDeviceAttributeMultiprocessorCount, dev) != hipSuccess) grid = -1;
            else if (hipFuncSetAttribute((const void*)mega_fwd, hipFuncAttributeMaxDynamicSharedMemorySize, LDS_BYTES) != hipSuccess) { fprintf(stderr, "kernel_launch: hipFuncSetAttribute failed\n"); grid = -1; }
            else {
                if (hipOccupancyMaxActiveBlocksPerMultiprocessor(&per_cu, (const void*)mega_fwd, 512, LDS_BYTES) != hipSuccess || per_cu < 1) fprintf(stderr, "kernel_launch: occupancy query reports %d blocks/CU\n", per_cu);
                (void)hipGetLastError();
                grid = (cus == NCU) ? cus : -1;
            }
        }
    }
    if (grid < 0) { hipLaunchKernelGGL(fill_zero, dim3(1024), dim3(256), 0, stream, (float*)d_out, out_size); return; }
    if (hipMemsetAsync((char*)d_ws + WS_CTL, 0, CTL_ZERO_BYTES, stream) != hipSuccess) return;
    Params p{};
    for (int i = 0; i < 22; ++i) p.in[i] = (const float*)d_in[i];
    p.out = (float*)d_out; p.ws = (unsigned char*)d_ws;
#if MK_ONE_LAUNCH
    p.ph_lo = 0; p.ph_hi = NPHASE;
    hipLaunchKernelGGL(mega_fwd, dim3(grid), dim3(512), LDS_BYTES, stream, p);
#else
    for (int k = 0; k < NPHASE; ++k) { p.ph_lo = k; p.ph_hi = k + 1; hipLaunchKernelGGL(mega_fwd, dim3(grid), dim3(512), LDS_BYTES, stream, p); }
#endif
}
```
